# Optimizing an MI355X kernel written in HIP

```python
import math
import jax, jax.numpy as jnp
from jax import lax
import numpy as np

D_MODEL = 1024
BATCH = 2
SEQ = 8192
DEPTH = 1
DEC_BATCH = 32
DEC_SEQ = 64
PAST_LEN = 4096

CHUNK = 64
EPS = 1e-6
POOL_WINDOWS = (2, 4, 8, 16)
N_POOL_GROUPS = 4
POOL_WIDTH = D_MODEL
POOL_GROUP = POOL_WIDTH // N_POOL_GROUPS
POOL_STATE = max(POOL_WINDOWS) - 1
SSM_EXPAND = 2
D_INNER = SSM_EXPAND * D_MODEL
SSM_HEAD_DIM = 64
N_SSM_HEADS = D_INNER // SSM_HEAD_DIM
N_SSM_GROUPS = 4
HEADS_PER_GROUP = N_SSM_HEADS // N_SSM_GROUPS
D_STATE = 128
CONV_WIDTH = 4
CONV_DIM = D_INNER + 2 * N_SSM_GROUPS * D_STATE
SSD_BLOCK = CHUNK
D_FF = ((8 * D_MODEL // 3 + 255) // 256) * 256
P_END = POOL_WIDTH
Z_END = P_END + D_INNER
XBC_END = Z_END + CONV_DIM
DT_END = XBC_END + N_SSM_HEADS
GA_END = DT_END + D_MODEL
N_IN = GA_END + D_MODEL

kernel_name = "pool_ssd_gated_hybrid_stream_step"


def _rmsnorm(x, w):
    xf = x.astype(jnp.float32)
    y = xf * lax.rsqrt(jnp.mean(xf * xf, axis=-1, keepdims=True) + EPS)
    return (y * w.astype(jnp.float32)).astype(x.dtype)


def _pool_mixer(p, p_hist, pos0, w_group, pool_scale):
    b, L, _ = p.shape
    full = jnp.concatenate([p_hist.astype(p.dtype), p], axis=1)
    pf = full.astype(jnp.float32)
    csum = jnp.concatenate([jnp.zeros((b, 1, POOL_WIDTH), jnp.float32), jnp.cumsum(pf, axis=1)], axis=1)
    end = csum[:, POOL_STATE + 1:]
    pos = pos0 + jnp.arange(L)
    outs = []
    for g, w in enumerate(POOL_WINDOWS):
        sl = slice(g * POOL_GROUP, (g + 1) * POOL_GROUP)
        start = csum[:, POOL_STATE + 1 - w: POOL_STATE + 1 - w + L, sl]
        cnt = jnp.minimum(pos + 1, w).astype(jnp.float32)[None, :, None]
        outs.append((end[..., sl] - start) / cnt - pf[:, POOL_STATE:, sl])
    m = jnp.stack(outs, axis=2)
    y = jnp.einsum('blgc,gcd->blgd', m, w_group.astype(jnp.float32)).reshape(b, L, POOL_WIDTH)
    y = y * pool_scale.astype(jnp.float32)
    return y.astype(p.dtype), full[:, -POOL_STATE:]


def _causal_conv(u, u_hist, w, bias):
    full = jnp.concatenate([u_hist.astype(u.dtype), u], axis=1)
    y = lax.conv_general_dilated(full, w[:, None, :].astype(u.dtype), (1,), 'VALID',
                                 dimension_numbers=('NWC', 'WIO', 'NWC'),
                                 feature_group_count=CONV_DIM)
    return y + bias, full[:, -(CONV_WIDTH - 1):]


def _ssd_scan(x, dt, A, Bm, Cm, h0, block):
    b, L = x.shape[:2]
    nc = L // block
    G, R, P, N = N_SSM_GROUPS, HEADS_PER_GROUP, SSM_HEAD_DIM, D_STATE
    f32 = jnp.float32
    x = x.reshape(b, nc, block, G, R, P).astype(f32)
    dt = dt.reshape(b, nc, block, G, R)
    Bm = Bm.reshape(b, nc, block, G, N).astype(f32)
    Cm = Cm.reshape(b, nc, block, G, N).astype(f32)
    acs = jnp.cumsum(dt * A.reshape(G, R), axis=2)
    mask = jnp.tril(jnp.ones((block, block), bool))[:, :, None, None]
    seg = acs[:, :, :, None] - acs[:, :, None, :]
    decay = jnp.exp(jnp.where(mask, seg, -jnp.inf))
    cb = jnp.einsum('bclgn,bcsgn->bclsg', Cm, Bm)
    y_diag = jnp.einsum('bclsg,bclsgr,bcsgr,bcsgrp->bclgrp', cb, decay, dt, x)
    decay_to_end = jnp.exp(acs[:, :, -1:] - acs)
    states = jnp.einsum('bclgn,bclgr,bclgrp->bcgrpn', Bm, decay_to_end * dt, x)
    block_decay = jnp.exp(acs[:, :, -1])

    def step(h, inp):
        s, d = inp
        return d[..., None, None] * h + s, h

    h_init = h0.reshape(b, G, R, P, N).astype(f32)
    h_last, h_prev = lax.scan(step, h_init, (jnp.moveaxis(states, 1, 0), jnp.moveaxis(block_decay, 1, 0)))
    h_prev = jnp.moveaxis(h_prev, 0, 1)
    y_off = jnp.einsum('bclgn,bcgrpn,bclgr->bclgrp', Cm, h_prev, jnp.exp(acs))
    y = (y_diag + y_off).reshape(b, L, N_SSM_HEADS, P)
    return y, h_last.reshape(b, N_SSM_HEADS, P, N)


def _ssd_mixer(z, xbc, dt_raw, conv_hist, h0, block, conv_w, conv_b, dt_bias, a_log, d_skip, norm_w):
    b, L, _ = z.shape
    xbc_c, new_conv = _causal_conv(xbc, conv_hist, conv_w, conv_b)
    xbc_c = jax.nn.silu(xbc_c)
    xs = xbc_c[..., :D_INNER].reshape(b, L, N_SSM_HEADS, SSM_HEAD_DIM)
    Bm = xbc_c[..., D_INNER:D_INNER + N_SSM_GROUPS * D_STATE].reshape(b, L, N_SSM_GROUPS, D_STATE)
    Cm = xbc_c[..., D_INNER + N_SSM_GROUPS * D_STATE:].reshape(b, L, N_SSM_GROUPS, D_STATE)
    dt = jax.nn.softplus(dt_raw.astype(jnp.float32) + dt_bias.astype(jnp.float32))
    A = -jnp.exp(a_log.astype(jnp.float32))
    y, h_last = _ssd_scan(xs, dt, A, Bm, Cm, h0, block)
    y = y + d_skip.astype(jnp.float32)[:, None] * xs.astype(jnp.float32)
    y = y.reshape(b, L, D_INNER) * jax.nn.silu(z.astype(jnp.float32))
    yg = y.reshape(b, L, N_SSM_GROUPS, D_INNER // N_SSM_GROUPS)
    yg = yg * lax.rsqrt(jnp.mean(yg * yg, axis=-1, keepdims=True) + EPS)
    y = yg.reshape(b, L, D_INNER) * norm_w.astype(jnp.float32)
    return y.astype(z.dtype), new_conv, h_last.astype(h0.dtype)


def _layer(x, c, pool_hist, conv_hist, ssm_h, pos0, block,
           w_ada, b_ada, norm1_w, norm2_w, w_in, pool_group_w, pool_scale, conv_w, conv_b,
           dt_bias, a_log, d_skip, ssm_norm_w, w_branch_a, w_branch_b, w_out,
           w_ffn_gate, w_ffn_up, w_ffn_down):
    mod = jax.nn.silu(c) @ w_ada + b_ada
    shift1, scale1, gate1, shift2, scale2, gate2 = jnp.split(mod[:, None, :], 6, axis=-1)
    h = _rmsnorm(x, norm1_w) * (1 + scale1) + shift1
    u = h @ w_in
    p = u[..., :P_END]
    z = u[..., P_END:Z_END]
    xbc = u[..., Z_END:XBC_END]
    dt_raw = u[..., XBC_END:DT_END]
    g_a = u[..., DT_END:GA_END]
    g_b = u[..., GA_END:]
    a_out, new_pool = _pool_mixer(p, pool_hist, pos0, pool_group_w, pool_scale)
    b_out, new_conv, new_ssm = _ssd_mixer(z, xbc, dt_raw, conv_hist, ssm_h, block, conv_w, conv_b,
                                          dt_bias, a_log, d_skip, ssm_norm_w)
    merged = jax.nn.sigmoid(g_a) * (a_out @ w_branch_a) + jax.nn.sigmoid(g_b) * (b_out @ w_branch_b)
    x = x + gate1 * (merged @ w_out)
    h2 = _rmsnorm(x, norm2_w) * (1 + scale2) + shift2
    f = (jax.nn.silu(h2 @ w_ffn_gate) * (h2 @ w_ffn_up)) @ w_ffn_down
    x = x + gate2 * f
    return x, new_pool, new_conv, new_ssm


def setup_inputs(seed: int = 0) -> dict:
    key = jax.random.key(seed)
    ks = jax.random.split(key, 32)
    f32 = jnp.float32

    def nrm(k, shape, scale):
        return jax.random.normal(k, shape, f32) * scale

    L = DEPTH
    dt_init = jnp.exp(jax.random.uniform(ks[16], (L, N_SSM_HEADS), f32, math.log(1e-3), math.log(1e-1)))
    return {
        "x_prompt": nrm(ks[0], (BATCH, SEQ, D_MODEL), 1.0),
        "x_sample": nrm(ks[1], (DEC_BATCH, DEC_SEQ, D_MODEL), 1.0),
        "c_prompt": nrm(ks[2], (BATCH, D_MODEL), 1.0),
        "c_sample": nrm(ks[3], (DEC_BATCH, D_MODEL), 1.0),
        "state_pool": nrm(ks[4], (L, DEC_BATCH, POOL_STATE, POOL_WIDTH), 1.0),
        "state_conv": nrm(ks[5], (L, DEC_BATCH, CONV_WIDTH - 1, CONV_DIM), 1.0),
        "state_ssm": nrm(ks[6], (L, DEC_BATCH, N_SSM_HEADS, SSM_HEAD_DIM, D_STATE), 0.1),
        "w_ada": nrm(ks[7], (L, D_MODEL, 6 * D_MODEL), 0.5 * D_MODEL ** -0.5),
        "b_ada": nrm(ks[8], (L, 6 * D_MODEL), 0.02),
        "norm1_w": 1.0 + nrm(ks[9], (L, D_MODEL), 0.02),
        "norm2_w": 1.0 + nrm(ks[10], (L, D_MODEL), 0.02),
        "w_in": nrm(ks[11], (L, D_MODEL, N_IN), D_MODEL ** -0.5),
        "pool_group_w": nrm(ks[12], (L, N_POOL_GROUPS, POOL_GROUP, POOL_GROUP), POOL_GROUP ** -0.5),
        "pool_scale": 1.0 + nrm(ks[13], (L, POOL_WIDTH), 0.1),
        "conv_w": nrm(ks[14], (L, CONV_WIDTH, CONV_DIM), CONV_WIDTH ** -0.5),
        "conv_b": nrm(ks[15], (L, CONV_DIM), 0.02),
        "dt_bias": dt_init + jnp.log(-jnp.expm1(-dt_init)),
        "a_log": jnp.log(jax.random.uniform(ks[17], (L, N_SSM_HEADS), f32, 1.0, 16.0)),
        "d_skip": 1.0 + nrm(ks[18], (L, N_SSM_HEADS), 0.1),
        "ssm_norm_w": 1.0 + nrm(ks[19], (L, D_INNER), 0.02),
        "w_branch_a": nrm(ks[20], (L, POOL_WIDTH, D_MODEL), POOL_WIDTH ** -0.5),
        "w_branch_b": nrm(ks[21], (L, D_INNER, D_MODEL), D_INNER ** -0.5),
        "w_out": nrm(ks[22], (L, D_MODEL, D_MODEL), D_MODEL ** -0.5),
        "w_ffn_gate": nrm(ks[23], (L, D_MODEL, D_FF), D_MODEL ** -0.5),
        "w_ffn_up": nrm(ks[24], (L, D_MODEL, D_FF), D_MODEL ** -0.5),
        "w_ffn_down": nrm(ks[25], (L, D_FF, D_MODEL), D_FF ** -0.5),
        "final_norm_w": 1.0 + nrm(ks[26], (D_MODEL,), 0.02),
    }


def reference(x_prompt, x_sample, c_prompt, c_sample, state_pool, state_conv, state_ssm,
              w_ada, b_ada, norm1_w, norm2_w, w_in, pool_group_w, pool_scale, conv_w, conv_b,
              dt_bias, a_log, d_skip, ssm_norm_w, w_branch_a, w_branch_b, w_out,
              w_ffn_gate, w_ffn_up, w_ffn_down, final_norm_w):
    xp, xs = x_prompt, x_sample
    bp = xp.shape[0]
    pool_p, conv_p, ssm_p, pool_s, conv_s, ssm_s = [], [], [], [], [], []
    for l in range(DEPTH):
        params = (w_ada[l], b_ada[l], norm1_w[l], norm2_w[l], w_in[l], pool_group_w[l], pool_scale[l],
                  conv_w[l], conv_b[l], dt_bias[l], a_log[l], d_skip[l], ssm_norm_w[l],
                  w_branch_a[l], w_branch_b[l], w_out[l], w_ffn_gate[l], w_ffn_up[l], w_ffn_down[l])
        xp, sp_, cp_, hp_ = _layer(
            xp, c_prompt,
            jnp.zeros((bp, POOL_STATE, POOL_WIDTH), xp.dtype),
            jnp.zeros((bp, CONV_WIDTH - 1, CONV_DIM), xp.dtype),
            jnp.zeros((bp, N_SSM_HEADS, SSM_HEAD_DIM, D_STATE), state_ssm.dtype),
            0, SSD_BLOCK, *params)
        xs, ss_, cs_, hs_ = _layer(
            xs, c_sample, state_pool[l], state_conv[l], state_ssm[l],
            PAST_LEN, xs.shape[1], *params)
        pool_p.append(sp_); conv_p.append(cp_); ssm_p.append(hp_)
        pool_s.append(ss_); conv_s.append(cs_); ssm_s.append(hs_)
    y_prompt = _rmsnorm(xp, final_norm_w)
    y_sample = _rmsnorm(xs, final_norm_w)
    return (y_prompt, y_sample,
            jnp.stack(pool_p), jnp.stack(conv_p), jnp.stack(ssm_p),
            jnp.stack(pool_s), jnp.stack(conv_s), jnp.stack(ssm_s))
```

```cpp
#include <hip/hip_runtime.h>
#include <hip/hip_cooperative_groups.h>
#include <cstdio>
namespace cg = cooperative_groups;

#ifndef MULTI_LAUNCH
#define MULTI_LAUNCH 0
#endif

#define LAS __attribute__((address_space(3)))
typedef unsigned short bf16_t;
typedef short bf16x8 __attribute__((ext_vector_type(8)));
typedef short bf16x4 __attribute__((ext_vector_type(4)));
typedef float f32x4 __attribute__((ext_vector_type(4)));
typedef float f32x2 __attribute__((ext_vector_type(2)));
typedef unsigned u32x4 __attribute__((ext_vector_type(4)));
typedef unsigned u32x2 __attribute__((ext_vector_type(2)));

constexpr int DM = 1024, HR = 9216  , NCHK = 144  ;
constexpr int NH = 32, DFF = 2816, NIN = 8224, NINP = 8448;
constexpr int LDS_BYTES = 131072;
#ifndef DIAG_K
#define DIAG_K -1
#endif
#ifndef SANITIZE
#define SANITIZE 0
#endif
constexpr int NPHASE = 27 + SANITIZE;

constexpr size_t WS_WIN = 0;
constexpr size_t WS_WGRP = WS_WIN + (size_t)NINP * 1024 * 2;
constexpr size_t WS_WA = WS_WGRP + (size_t)1024 * 256 * 2;
constexpr size_t WS_WB = WS_WA + (size_t)1024 * 1024 * 2;
constexpr size_t WS_WOUT = WS_WB + (size_t)1024 * 2048 * 2;
constexpr size_t WS_WF1 = WS_WOUT + (size_t)1024 * 1024 * 2;
constexpr size_t WS_WF2 = WS_WF1 + (size_t)5632 * 1024 * 2;
constexpr size_t WS_MOD = WS_WF2 + (size_t)1024 * 2816 * 2;
constexpr size_t WS_H = WS_MOD + (size_t)34 * 6144 * 4;
constexpr size_t WS_Z = WS_H + (size_t)HR * 1024 * 2;
constexpr size_t WS_X = WS_Z + (size_t)HR * 2048 * 2;
constexpr size_t WS_AM = WS_X + (size_t)HR * 2048 * 2;
constexpr size_t WS_GB = WS_X + (size_t)HR * 3072 * 2;
constexpr size_t WS_XT = WS_GB + (size_t)HR * 1024 * 2;
constexpr size_t WS_BT = WS_XT + (size_t)HR * 2048 * 2;
constexpr size_t WS_CM = WS_BT + (size_t)NCHK * 4 * 128 * 64 * 2;
constexpr size_t WS_BM = WS_CM + (size_t)NCHK * 4 * 128 * 64 * 2;
constexpr size_t WS_CB = WS_BM + (size_t)NCHK * 4 * 128 * 64 * 2;
constexpr size_t WS_ST = WS_CB + (size_t)NCHK * 4 * 64 * 64 * 2;
constexpr size_t WS_DTR = WS_ST + (size_t)15 * 32 * 64 * 128 * 4;
constexpr size_t WS_DTC = WS_DTR + (size_t)HR * 32 * 4;
constexpr size_t WS_ACS = WS_DTC + (size_t)HR * 32 * 4;
constexpr size_t WS_END = WS_ACS + (size_t)HR * 32 * 4;
static_assert(WS_END <= (size_t)256 * 1024 * 1024, "workspace");

constexpr size_t O_Y = 0;
constexpr size_t O_POOLP = 18874368;
constexpr size_t O_CONVP = O_POOLP + 30720;
constexpr size_t O_SSMP = O_CONVP + 18432;
constexpr size_t O_POOLS = O_SSMP + 524288;
constexpr size_t O_CONVS = O_POOLS + 491520;
constexpr size_t O_SSMS = O_CONVS + 294912;

struct Params {
    const float* in[27];
    float* out;
    unsigned char* ws;
    int ph_lo, ph_hi;
};

typedef __bf16 bfx2_t __attribute__((ext_vector_type(2)));
__device__ __forceinline__ unsigned cvt_pk_bf16(float lo, float hi) { const f32x2 v = {lo, hi}; return __builtin_bit_cast(unsigned, __builtin_convertvector(v, bfx2_t)); }
__device__ __forceinline__ float bf2f(short b) { return __uint_as_float(((unsigned)(unsigned short)b) << 16); }
__device__ __forceinline__ float bflo(unsigned w) { return __uint_as_float(w << 16); }
__device__ __forceinline__ float bfhi(unsigned w) { return __uint_as_float(w & 0xffff0000u); }
__device__ __forceinline__ float sigmoidf_(float x) { return 1.0f / (1.0f + __expf(-x)); }
__device__ __forceinline__ float siluf_(float x) { return x / (1.0f + __expf(-x)); }
__device__ __forceinline__ int segoff(int half, int pm) { return pm < 32 ? half * 8192 : 8192 + half * 1024; }
__device__ __forceinline__ int gtok(int half, int r) { return r + (r < 8192 ? half * 8192 : 8192 + half * 1024); }
__device__ __forceinline__ int modrow(int half, int r) { return r < 8192 ? half : 2 + 16 * half + ((r - 8192) >> 6); }
__device__ __forceinline__ int otid() { int t = threadIdx.x; asm volatile("" : "+v"(t)); return t; }
__device__ __forceinline__ int obid() { int b = blockIdx.x; asm volatile("" : "+s"(b)); return b; }
__device__ __forceinline__ float wave_sum(float v) {
#pragma unroll
    for (int o = 32; o > 0; o >>= 1) v += __shfl_xor(v, o, 64);
    return v;
}

namespace pg8 {
constexpr int BM = 256, BK = 64, HALF = 128, HTB = HALF * BK * 2, STAGE_BYTES = 8 * HTB, NXCD = 8, WGM = 8;
__device__ __forceinline__ int lds_byte(int r, int c) { const int st = (r >> 4) * 2 + (c >> 5), rr = r & 15, cc = c & 31, ob = rr * 64 + cc * 2; return st * 1024 + (ob ^ (((ob >> 9) & 1) << 5)); }
__device__ __forceinline__ void stage_rc(int b, int& R, int& C) { const int st = b / 1024, sb = b % 1024, swz = sb ^ (((sb >> 9) & 1) << 5); R = (st >> 1) * 16 + swz / 64; C = (st & 1) * 32 + (swz % 64) / 2; }
__device__ __forceinline__ int perm32(int rho) { const int n = rho >> 4, i = rho & 15; return 8 * (i >> 2) + 4 * n + (i & 3); }
struct Unit { int pm, pn; };
struct Gemm { const bf16_t* A; const bf16_t* Bt; int M, N, K, lda, ldb, acoff; };
struct StaticOrder {
    int nM, nN, nwg, G, c;
    __device__ void init(int M, int N, int G_, int c_) { nM = M / BM; nN = N / BM; nwg = nM * nN; G = G_; c = c_; }
    __device__ bool next(int i, Unit& u) const {
        const long L = (long)i * G + c; if (L >= nwg) return false;
        int wgid = (int)L; { const int q = nwg / NXCD, r = nwg % NXCD, xcd = wgid % NXCD, off = wgid / NXCD; wgid = (xcd < r ? xcd * (q + 1) : r * (q + 1) + (xcd - r) * q) + off; }
        const int nig = WGM * nN, gid = wgid / nig, fm = gid * WGM, gsz = (nM - fm) < WGM ? (nM - fm) : WGM;
        u.pm = fm + ((wgid % nig) % gsz); u.pn = (wgid % nig) / gsz; return true;
    }
};

template <class Epi>
__device__ __forceinline__ void gemm_phase(LAS unsigned char* lds, const Gemm g, const StaticOrder& S, const Epi& E) {
    const int tid = otid(), wid = __builtin_amdgcn_readfirstlane(tid >> 6), lane = tid & 63, wr = wid >> 2, wc = wid & 3, fr = lane & 15, fq = lane >> 4;
    const int nt = g.K / BK;
    unsigned voffA[2], voffB[2];
#pragma unroll
    for (int i = 0; i < 2; ++i) { int R, C; stage_rc(tid * 16 + i * 8192, R, C); const int Rb = Epi::PERM ? ((R & ~31) + perm32(R & 31)) : R;
        voffA[i] = (unsigned)(R * g.lda + C) * 2u; voffB[i] = (unsigned)(Rb * g.ldb + C) * 2u; }
    const size_t kstep = (size_t)(BK * 2);
    const size_t hstepA = (size_t)HALF * g.lda * 2, hstepB = (size_t)HALF * g.ldb * 2;
    const size_t tstepA = 2 * hstepA, tstepB = 2 * hstepB;
    const unsigned ldsw = (unsigned)wid * 1024u;
    const int aoff = lds_byte(wr * 64 + fr, fq * 8), boff = lds_byte(wc * 32 + fr, fq * 8);
#define PG8_SA(b, h) (((b) * 2 + (h)) * HTB)
#define PG8_SB(b, h) ((4 + (b) * 2 + (h)) * HTB)
#define PG8_STAGE(bufoff, gbase, voff) do { _Pragma("unroll") for (int _i = 0; _i < 2; ++_i) \
        __builtin_amdgcn_global_load_lds((const unsigned*)((const char*)(gbase) + (voff)[_i]), (LAS unsigned*)(lds + (bufoff) + ldsw + _i * 8192), 16, 0, 0); } while (0)
#define PG8_LDA(dst, b, h) do { _Pragma("unroll") for (int m = 0; m < 4; ++m) _Pragma("unroll") for (int k = 0; k < 2; ++k) dst[m][k] = *(const LAS bf16x8*)(lds + PG8_SA(b, h) + aoff + m * 2048 + k * 1024); } while (0)
#define PG8_LDB(dst, b, h) do { _Pragma("unroll") for (int n = 0; n < 2; ++n) _Pragma("unroll") for (int k = 0; k < 2; ++k) dst[n][k] = *(const LAS bf16x8*)(lds + PG8_SB(b, h) + boff + n * 2048 + k * 1024); } while (0)
#define PG8_MMA(ai, bj, At, Bt) do { __builtin_amdgcn_s_setprio(1); _Pragma("unroll") for (int m = 0; m < 4; ++m) _Pragma("unroll") for (int n = 0; n < 2; ++n) _Pragma("unroll") for (int k = 0; k < 2; ++k) \
        acc[ai][bj][m][n] = __builtin_amdgcn_mfma_f32_16x16x32_bf16(Bt[n][k], At[m][k], acc[ai][bj][m][n], 0, 0, 0); __builtin_amdgcn_s_setprio(0); } while (0)
#define PG8_WAIT_V(n) asm volatile("s_waitcnt vmcnt(" #n ")" ::: "memory")
#define PG8_WAIT_L(n) asm volatile("s_waitcnt lgkmcnt(" #n ")" ::: "memory")
#define PG8_BAR __builtin_amdgcn_s_barrier()
#define PG8_SCHED __builtin_amdgcn_sched_barrier(0)
    Unit cur, nxt; int ui = 0;
    if (!S.next(0, cur)) return;
    f32x4 acc[2][2][4][2];
#pragma unroll
    for (int a = 0; a < 2; ++a)
#pragma unroll
        for (int b = 0; b < 2; ++b)
#pragma unroll
            for (int m = 0; m < 4; ++m)
#pragma unroll
                for (int n = 0; n < 2; ++n) acc[a][b][m][n] = (f32x4){0.f, 0.f, 0.f, 0.f};
    bf16x8 At[4][2], B0[2][2], B1[2][2];
    const char* cA = (const char*)g.A + (size_t)cur.pm * tstepA + (size_t)cur.pn * g.acoff * 2; const char* cB = (const char*)g.Bt + (size_t)cur.pn * tstepB;
    PG8_STAGE(PG8_SB(0, 0), cB, voffB); PG8_STAGE(PG8_SA(0, 0), cA, voffA); PG8_STAGE(PG8_SB(0, 1), cB + hstepB, voffB); PG8_STAGE(PG8_SA(0, 1), cA + hstepA, voffA);
    if (wr == 1) PG8_BAR;
    PG8_WAIT_V(4); PG8_BAR;
    PG8_STAGE(PG8_SB(1, 0), cB + kstep, voffB); PG8_STAGE(PG8_SA(1, 0), cA + kstep, voffA); PG8_STAGE(PG8_SB(1, 1), cB + hstepB + kstep, voffB);
    PG8_WAIT_V(6); PG8_BAR;
    for (;;) {
        const bool has_next = S.next(ui + 1, nxt);
        const char* nA = has_next ? (const char*)g.A + (size_t)nxt.pm * tstepA + (size_t)nxt.pn * g.acoff * 2 : cA; const char* nB = has_next ? (const char*)g.Bt + (size_t)nxt.pn * tstepB : cB;
#pragma unroll 1
        for (int t = 0; t < nt; t += 2) {
            const bool last = (t == nt - 2);
            const char* a1 = cA + (size_t)(t + 1) * kstep;
            const char* a2 = last ? nA : cA + (size_t)(t + 2) * kstep; const char* b2 = last ? nB : cB + (size_t)(t + 2) * kstep;
            const char* a3 = a2 + kstep; const char* b3 = b2 + kstep;
            PG8_LDB(B0, 0, 0); PG8_SCHED; PG8_LDA(At, 0, 0); PG8_STAGE(PG8_SA(1, 1), a1 + hstepA, voffA);
            PG8_WAIT_L(8); PG8_BAR; PG8_WAIT_L(0); PG8_MMA(0, 0, At, B0); PG8_BAR; PG8_SCHED;
            PG8_LDB(B1, 0, 1); PG8_STAGE(PG8_SB(0, 0), b2, voffB);
            PG8_BAR; PG8_WAIT_L(0); PG8_MMA(0, 1, At, B1); PG8_BAR;
            PG8_LDA(At, 0, 1); PG8_STAGE(PG8_SA(0, 0), a2, voffA);
            PG8_BAR; PG8_WAIT_L(0); PG8_MMA(1, 0, At, B0); PG8_BAR; PG8_SCHED;
            PG8_STAGE(PG8_SB(0, 1), b2 + hstepB, voffB);
            PG8_WAIT_V(6); PG8_BAR; PG8_MMA(1, 1, At, B1); PG8_BAR;
            PG8_LDB(B0, 1, 0); PG8_SCHED; PG8_LDA(At, 1, 0); PG8_STAGE(PG8_SA(0, 1), a2 + hstepA, voffA);
            PG8_WAIT_L(8); PG8_BAR; PG8_WAIT_L(0); PG8_MMA(0, 0, At, B0); PG8_BAR; PG8_SCHED;
            PG8_LDB(B1, 1, 1); PG8_STAGE(PG8_SB(1, 0), b3, voffB);
            PG8_BAR; PG8_WAIT_L(0); PG8_MMA(0, 1, At, B1); PG8_BAR;
            PG8_LDA(At, 1, 1); PG8_STAGE(PG8_SA(1, 0), a3, voffA);
            PG8_BAR; PG8_WAIT_L(0); PG8_MMA(1, 0, At, B0); PG8_BAR; PG8_SCHED;
            PG8_STAGE(PG8_SB(1, 1), b3 + hstepB, voffB);
            PG8_WAIT_V(6); PG8_BAR; PG8_MMA(1, 1, At, B1); PG8_BAR;
        }
        E(acc, cur, wr, wc, fr, fq);
        if (!has_next) break;
#pragma unroll
        for (int a = 0; a < 2; ++a)
#pragma unroll
            for (int b = 0; b < 2; ++b)
#pragma unroll
                for (int m = 0; m < 4; ++m)
#pragma unroll
                    for (int n = 0; n < 2; ++n) acc[a][b][m][n] = (f32x4){0.f, 0.f, 0.f, 0.f};
        cur = nxt; cA = nA; cB = nB; ++ui;
    }
    PG8_WAIT_V(0);
    if (wr == 0) PG8_BAR;
    PG8_BAR;
#undef PG8_SA
#undef PG8_SB
#undef PG8_STAGE
#undef PG8_LDA
#undef PG8_LDB
#undef PG8_MMA
#undef PG8_WAIT_V
#undef PG8_WAIT_L
#undef PG8_BAR
#undef PG8_SCHED
}
}
using pg8::Unit;
typedef f32x4 AccT[2][2][4][2];

struct EpiIn {
    static constexpr bool PERM = true;
    unsigned char* ws; float* out; int half;
    __device__ __forceinline__ void operator()(const AccT& acc, const Unit& u, int wr, int wc, int fr, int fq) const {
        const int pn = u.pn; const int row0 = u.pm * 256 + wr * 64 + fr;
        if (pn == 32) {
            if (wc == 0) { float* D = (float*)(ws + WS_DTR);
#pragma unroll
                for (int ai = 0; ai < 2; ++ai)
#pragma unroll
                    for (int m = 0; m < 4; ++m) { const int r = row0 + ai * 128 + m * 16;
                        *(f32x4*)(D + (size_t)r * 32 + 8 * fq) = acc[ai][0][m][0]; *(f32x4*)(D + (size_t)r * 32 + 8 * fq + 4) = acc[ai][0][m][1]; } }
            return; }
        bf16_t* base; int ld, radd = 0, c0; bool sig = false;
        if (pn < 4) { base = (bf16_t*)out; ld = 2048; radd = segoff(half, u.pm); c0 = pn * 256; }
        else if (pn < 12) { base = (bf16_t*)(ws + WS_Z); ld = 2048; c0 = (pn - 4) * 256; }
        else if (pn < 24) { base = (bf16_t*)(ws + WS_X); ld = 3072; c0 = (pn - 12) * 256; }
        else if (pn < 28) { base = (bf16_t*)out + 1024; ld = 2048; radd = segoff(half, u.pm); c0 = (pn - 24) * 256; sig = true; }
        else { base = (bf16_t*)(ws + WS_GB); ld = 1024; c0 = (pn - 28) * 256; sig = true; }
        const int col0 = c0 + wc * 32 + 8 * fq;
#pragma unroll
        for (int ai = 0; ai < 2; ++ai)
#pragma unroll
            for (int m = 0; m < 4; ++m) { bf16_t* rowp = base + (size_t)(row0 + radd + ai * 128 + m * 16) * ld + col0;
#pragma unroll
                for (int bj = 0; bj < 2; ++bj) { f32x4 v0 = acc[ai][bj][m][0], v1 = acc[ai][bj][m][1];
                    if (sig) {
#pragma unroll
                        for (int j = 0; j < 4; ++j) { v0[j] = sigmoidf_(v0[j]); v1[j] = sigmoidf_(v1[j]); } }
                    u32x4 w; w.x = cvt_pk_bf16(v0[0], v0[1]); w.y = cvt_pk_bf16(v0[2], v0[3]); w.z = cvt_pk_bf16(v1[0], v1[1]); w.w = cvt_pk_bf16(v1[2], v1[3]);
                    *(u32x4*)(rowp + bj * 128) = w; } }
    }
};
struct EpiPool {
    static constexpr bool PERM = true;
    bf16_t* O; const float* scale;
    __device__ __forceinline__ void operator()(const AccT& acc, const Unit& u, int wr, int wc, int fr, int fq) const {
        const int row0 = u.pm * 256 + wr * 64 + fr, col0 = u.pn * 256 + wc * 32 + 8 * fq;
        f32x4 sv[2][2];
#pragma unroll
        for (int bj = 0; bj < 2; ++bj)
#pragma unroll
            for (int n = 0; n < 2; ++n) sv[bj][n] = *(const f32x4*)(scale + col0 + bj * 128 + 4 * n);
#pragma unroll
        for (int ai = 0; ai < 2; ++ai)
#pragma unroll
            for (int m = 0; m < 4; ++m) { bf16_t* rowp = O + (size_t)(row0 + ai * 128 + m * 16) * 1024 + col0;
#pragma unroll
                for (int bj = 0; bj < 2; ++bj) { f32x4 v0 = acc[ai][bj][m][0] * sv[bj][0], v1 = acc[ai][bj][m][1] * sv[bj][1];
                    u32x4 w; w.x = cvt_pk_bf16(v0[0], v0[1]); w.y = cvt_pk_bf16(v0[2], v0[3]); w.z = cvt_pk_bf16(v1[0], v1[1]); w.w = cvt_pk_bf16(v1[2], v1[3]);
                    *(u32x4*)(rowp + bj * 128) = w; } }
    }
};
struct EpiA {
    static constexpr bool PERM = true;
    bf16_t* O; const bf16_t* GA  ; int half;
    __device__ __forceinline__ void operator()(const AccT& acc, const Unit& u, int wr, int wc, int fr, int fq) const {
        const int row0 = u.pm * 256 + wr * 64 + fr, col0 = u.pn * 256 + wc * 32 + 8 * fq, radd = segoff(half, u.pm);
#pragma unroll
        for (int ai = 0; ai < 2; ++ai)
#pragma unroll
            for (int m = 0; m < 4; ++m) { const int r = row0 + ai * 128 + m * 16; bf16_t* rowp = O + (size_t)r * 1024 + col0; const bf16_t* gp = GA + (size_t)(r + radd) * 2048 + col0;
#pragma unroll
                for (int bj = 0; bj < 2; ++bj) { const u32x4 gv = *(const u32x4*)(gp + bj * 128); const f32x4 v0 = acc[ai][bj][m][0], v1 = acc[ai][bj][m][1];
                    u32x4 w; w.x = cvt_pk_bf16(v0[0] * bflo(gv.x), v0[1] * bfhi(gv.x)); w.y = cvt_pk_bf16(v0[2] * bflo(gv.y), v0[3] * bfhi(gv.y));
                    w.z = cvt_pk_bf16(v1[0] * bflo(gv.z), v1[1] * bfhi(gv.z)); w.w = cvt_pk_bf16(v1[2] * bflo(gv.w), v1[3] * bfhi(gv.w));
                    *(u32x4*)(rowp + bj * 128) = w; } }
    }
};
struct EpiB {
    static constexpr bool PERM = true;
    bf16_t* GBM; const bf16_t* MA;
    __device__ __forceinline__ void operator()(const AccT& acc, const Unit& u, int wr, int wc, int fr, int fq) const {
        const int row0 = u.pm * 256 + wr * 64 + fr, col0 = u.pn * 256 + wc * 32 + 8 * fq;
#pragma unroll
        for (int ai = 0; ai < 2; ++ai)
#pragma unroll
            for (int m = 0; m < 4; ++m) { const size_t ro = (size_t)(row0 + ai * 128 + m * 16) * 1024 + col0;
#pragma unroll
                for (int bj = 0; bj < 2; ++bj) { const u32x4 gv = *(const u32x4*)(GBM + ro + bj * 128); const u32x4 av = *(const u32x4*)(MA + ro + bj * 128); const f32x4 v0 = acc[ai][bj][m][0], v1 = acc[ai][bj][m][1];
                    u32x4 w; w.x = cvt_pk_bf16(bflo(av.x) + v0[0] * bflo(gv.x), bfhi(av.x) + v0[1] * bfhi(gv.x)); w.y = cvt_pk_bf16(bflo(av.y) + v0[2] * bflo(gv.y), bfhi(av.y) + v0[3] * bfhi(gv.y));
                    w.z = cvt_pk_bf16(bflo(av.z) + v1[0] * bflo(gv.z), bfhi(av.z) + v1[1] * bfhi(gv.z)); w.w = cvt_pk_bf16(bflo(av.w) + v1[2] * bflo(gv.w), bfhi(av.w) + v1[3] * bfhi(gv.w));
                    *(u32x4*)(GBM + ro + bj * 128) = w; } }
    }
};
struct EpiRes {
    static constexpr bool PERM = false;
    float* dst; const float* xp; const float* xs; const float* mod; int goff; int half; int inplace;
    __device__ __forceinline__ void operator()(const AccT& acc, const Unit& u, int wr, int wc, int fr, int fq) const {
        const int row0 = u.pm * 256 + wr * 64 + fr, col0 = u.pn * 256 + wc * 32 + 4 * fq;
#pragma unroll
        for (int ai = 0; ai < 2; ++ai)
#pragma unroll
            for (int m = 0; m < 4; ++m) { const int r = row0 + ai * 128 + m * 16; const int gt = gtok(half, r);
                float* dp = dst + (size_t)gt * 1024 + col0;
                const float* sp = inplace ? dp : (r < 8192 ? xp + (size_t)(half * 8192 + r) * 1024 + col0 : xs + (size_t)(half * 1024 + r - 8192) * 1024 + col0);
                const float* gp = mod + (size_t)modrow(half, r) * 6144 + goff + col0;
#pragma unroll
                for (int bj = 0; bj < 2; ++bj)
#pragma unroll
                    for (int n = 0; n < 2; ++n) { const int o = bj * 128 + n * 16; const f32x4 s = *(const f32x4*)(sp + o), gg = *(const f32x4*)(gp + o);
                        *(f32x4*)(dp + o) = s + gg * acc[ai][bj][m][n]; } }
    }
};
struct EpiF1 {
    static constexpr bool PERM = false;
    bf16_t* O;
    __device__ __forceinline__ void operator()(const AccT& acc, const Unit& u, int wr, int wc, int fr, int fq) const {
        const int row0 = u.pm * 256 + wr * 64 + fr, col0 = u.pn * 128 + wc * 16 + 4 * fq;
#pragma unroll
        for (int ai = 0; ai < 2; ++ai)
#pragma unroll
            for (int m = 0; m < 4; ++m) { bf16_t* rowp = O + (size_t)(row0 + ai * 128 + m * 16) * DFF + col0;
#pragma unroll
                for (int bj = 0; bj < 2; ++bj) { const f32x4 a = acc[ai][bj][m][0], b = acc[ai][bj][m][1];
                    u32x2 w; w.x = cvt_pk_bf16(siluf_(a[0]) * b[0], siluf_(a[1]) * b[1]); w.y = cvt_pk_bf16(siluf_(a[2]) * b[2], siluf_(a[3]) * b[3]);
                    *(u32x2*)(rowp + bj * 64) = w; } }
    }
};

__device__ __forceinline__ const float* wsrc(const Params& p, int w, int r, int& ld) {
    switch (w) {
    case 0: { ld = NIN; const float* b = p.in[11]; if (r < 6144) return b + r; if (r < 8192) return b + r + 32; if (r < 8224) return b + 6144 + (r - 8192); return nullptr; }
    case 1: ld = 256; return p.in[12] + (size_t)(r >> 8) * 65536 + (r & 255);
    case 2: ld = 1024; return p.in[20] + r;
    case 3: ld = 1024; return p.in[21] + r;
    case 4: ld = 1024; return p.in[22] + r;
    case 5: { ld = DFF; const int pn = r >> 8, bj = (r >> 7) & 1, wc = (r >> 5) & 3, n = (r >> 4) & 1, fq = (r >> 2) & 3, e = r & 3; const int G = pn * 128 + bj * 64 + wc * 16 + fq * 4 + e; return (n ? p.in[24] : p.in[23]) + G; }
    default: ld = 1024; return p.in[25] + r;
    }
}
__device__ __forceinline__ void phase0(const Params& p, float* lds) {
    const int t = otid(), bid = obid();
    const int total_tiles = 2112 + 64 + 256 + 512 + 256 + 1408 + 704;
    for (int item = bid; item < 96 + total_tiles; item += gridDim.x) {
        if (item < 96) {
            const int slab = item, jc = t & 63, kg = t >> 6;
            float acc[34];
#pragma unroll
            for (int b = 0; b < 34; ++b) acc[b] = 0.f;
            for (int kh = 0; kh < 2; ++kh) {
                __syncthreads();
                for (int o = t; o < 34 * 512; o += 512) { const int b = o >> 9, kk = o & 511; const float cv = (b < 2 ? p.in[2] + b * 1024 : p.in[3] + (b - 2) * 1024)[kh * 512 + kk]; lds[o] = siluf_(cv); }
                __syncthreads();
                for (int kk = kg * 64; kk < kg * 64 + 64; ++kk) { const float wv = p.in[7][(size_t)(kh * 512 + kk) * 6144 + slab * 64 + jc];
#pragma unroll
                    for (int b = 0; b < 34; ++b) acc[b] += lds[b * 512 + kk] * wv; }
            }
            __syncthreads();
#pragma unroll
            for (int b = 0; b < 34; ++b) lds[(kg * 34 + b) * 64 + jc] = acc[b];
            __syncthreads();
            for (int o = t; o < 34 * 64; o += 512) { const int b = o >> 6, j = o & 63; float s = 0.f;
#pragma unroll
                for (int k8 = 0; k8 < 8; ++k8) s += lds[(k8 * 34 + b) * 64 + j];
                ((float*)(p.ws + WS_MOD))[b * 6144 + slab * 64 + j] = s + p.in[8][slab * 64 + j]; }
            __syncthreads();
        } else {
            int ti = item - 96, w, ktw; size_t wow;
            if (ti < 2112) { w = 0; ktw = 16; wow = WS_WIN; }
            else if ((ti -= 2112) < 64) { w = 1; ktw = 4; wow = WS_WGRP; }
            else if ((ti -= 64) < 256) { w = 2; ktw = 16; wow = WS_WA; }
            else if ((ti -= 256) < 512) { w = 3; ktw = 32; wow = WS_WB; }
            else if ((ti -= 512) < 256) { w = 4; ktw = 16; wow = WS_WOUT; }
            else if ((ti -= 256) < 1408) { w = 5; ktw = 16; wow = WS_WF1; }
            else { ti -= 1408; w = 6; ktw = 44; wow = WS_WF2; }
            const int K = ktw * 64, r0 = (ti / ktw) * 64, k0 = (ti % ktw) * 64;
            { const int rr = t & 63, kq = t >> 6; int ld; const float* sp = wsrc(p, w, r0 + rr, ld);
#pragma unroll
                for (int i = 0; i < 8; ++i) { const int kl = kq + 8 * i; lds[kl * 65 + rr] = sp ? sp[(size_t)(k0 + kl) * ld] : 0.f; } }
            __syncthreads();
            { const int ro = t >> 3, kk = (t & 7) * 8; float v[8];
#pragma unroll
                for (int j = 0; j < 8; ++j) v[j] = lds[(kk + j) * 65 + ro];
                u32x4 o; o.x = cvt_pk_bf16(v[0], v[1]); o.y = cvt_pk_bf16(v[2], v[3]); o.z = cvt_pk_bf16(v[4], v[5]); o.w = cvt_pk_bf16(v[6], v[7]);
                *(u32x4*)((bf16_t*)(p.ws + wow) + (size_t)(r0 + ro) * K + k0 + kk) = o; }
            __syncthreads();
        }
    }
}

template <int MODE>
__device__ __forceinline__ void norm_phase(const Params& p, int half) {
    const int t_ = otid(), bid = obid(); const int lane = t_ & 63, wv = t_ >> 6;
    const float* w = MODE == 0 ? p.in[9] : (MODE == 1 ? p.in[10] : p.in[26]);
    f32x4 wq[4];
#pragma unroll
    for (int i = 0; i < 4; ++i) wq[i] = *(const f32x4*)(w + i * 256 + lane * 4);
    for (int r = bid * 8 + wv; r < HR; r += gridDim.x * 8) {
        const float* src;
        if (MODE == 0) src = r < 8192 ? p.in[0] + (size_t)(half * 8192 + r) * 1024 : p.in[1] + (size_t)(half * 1024 + r - 8192) * 1024;
        else src = p.out + (size_t)gtok(half, r) * 1024;
        f32x4 v[4]; float ss = 0.f;
#pragma unroll
        for (int i = 0; i < 4; ++i) { v[i] = *(const f32x4*)(src + i * 256 + lane * 4); ss += v[i][0] * v[i][0] + v[i][1] * v[i][1] + v[i][2] * v[i][2] + v[i][3] * v[i][3]; }
        ss = wave_sum(ss);
        const float rstd = rsqrtf(ss * (1.0f / 1024.0f) + 1e-6f);
        if (MODE == 2) {
            float* dst = p.out + (size_t)gtok(half, r) * 1024;
#pragma unroll
            for (int i = 0; i < 4; ++i) *(f32x4*)(dst + i * 256 + lane * 4) = v[i] * rstd * wq[i];
        } else {
            const float* mr = (const float*)(p.ws + WS_MOD) + (size_t)modrow(half, r) * 6144 + (MODE == 0 ? 0 : 3072);
            bf16_t* dst = (bf16_t*)(p.ws + WS_H) + (size_t)r * 1024;
#pragma unroll
            for (int i = 0; i < 4; ++i) { const f32x4 sh = *(const f32x4*)(mr + i * 256 + lane * 4), sc = *(const f32x4*)(mr + 1024 + i * 256 + lane * 4);
                const f32x4 y = (v[i] * rstd * wq[i]) * (sc + 1.0f) + sh;
                u32x2 o; o.x = cvt_pk_bf16(y[0], y[1]); o.y = cvt_pk_bf16(y[2], y[3]); *(u32x2*)(dst + i * 256 + lane * 4) = o; }
        }
    }
}

template <int W>
__device__ __forceinline__ void pool_tile(const Params& p, int half, int lc, int ch0, int t) {
    const int ch = ch0 + (t & 63), l0 = (t >> 6) * 8;
    const bool sample = lc >= 128, first = sample || lc == 0;
    const int sb = 16 * half + lc - 128;
    const int r0 = lc * 64, radd = sample ? 8192 + half * 1024 : half * 8192;
    const bf16_t* P = (const bf16_t*)p.out;
    float v[23];
#pragma unroll
    for (int i = 0; i < 23; ++i) { const int l = l0 - 15 + i;
        if (l >= 0 || !first) v[i] = bf2f((short)P[(size_t)(r0 + l + radd) * 2048 + ch]);
        else v[i] = sample ? p.in[4][((size_t)sb * 15 + 15 + l) * 1024 + ch] : 0.f; }
    float S = 0.f;
#pragma unroll
    for (int j = 0; j < W; ++j) S += v[15 - j];
    bf16_t* M = (bf16_t*)(p.ws + WS_H);
#pragma unroll
    for (int i = 0; i < 8; ++i) {
        if (i > 0) S += v[15 + i] - v[15 + i - W];
        const int l = l0 + i; const int pos1 = sample ? 4097 + l : r0 + l + 1;
        const float cnt = (float)(pos1 < W ? pos1 : W);
        const float mv = S / cnt - v[15 + i];
        M[(size_t)(r0 + l) * 1024 + ch] = (bf16_t)(cvt_pk_bf16(mv, 0.f) & 0xffffu);
        if ((sample || lc == 127) && l >= 49) {
            float* o = sample ? p.out + O_POOLS + ((size_t)sb * 15 + (l - 49)) * 1024 + ch : p.out + O_POOLP + ((size_t)half * 15 + (l - 49)) * 1024 + ch;
            *o = v[15 + i]; }
    }
}
__device__ __forceinline__ void s1_phase(const Params& p, int half) {
    const int t = otid(), bid = obid();
    for (int item = bid; item < NCHK * 65; item += gridDim.x) {
        const int lc = item / 65, sub = item % 65;
        const bool sample = lc >= 128, first = sample || lc == 0;
        const int sb = 16 * half + lc - 128;
        const int r0 = lc * 64;
        if (sub < 48) {
            const int col = (sub < 32 ? sub * 64 : (sub < 40 ? 2048 + (sub - 32) * 64 : 2560 + (sub - 40) * 64)) + (t & 63);
            const int l0 = (t >> 6) * 8;
            const bf16_t* X = (const bf16_t*)(p.ws + WS_X);
            float v[11];
#pragma unroll
            for (int i = 0; i < 11; ++i) { const int l = l0 - 3 + i;
                if (l >= 0 || !first) v[i] = bf2f((short)X[(size_t)(r0 + l) * 3072 + col]);
                else v[i] = sample ? p.in[5][((size_t)sb * 3 + 3 + l) * 3072 + col] : 0.f; }
            const float w0 = p.in[14][col], w1 = p.in[14][3072 + col], w2 = p.in[14][2 * 3072 + col], w3 = p.in[14][3 * 3072 + col], cb = p.in[15][col];
            float o[8];
#pragma unroll
            for (int j = 0; j < 8; ++j) o[j] = siluf_(cb + w0 * v[j] + w1 * v[j + 1] + w2 * v[j + 2] + w3 * v[j + 3]);
            u32x4 pk; pk.x = cvt_pk_bf16(o[0], o[1]); pk.y = cvt_pk_bf16(o[2], o[3]); pk.z = cvt_pk_bf16(o[4], o[5]); pk.w = cvt_pk_bf16(o[6], o[7]);
            if (sub < 32) {
                *(u32x4*)((bf16_t*)(p.ws + WS_XT) + (((size_t)lc * 32 + sub) * 64 + (t & 63)) * 64 + l0) = pk;
            } else {
                const int gi = (sub < 40 ? sub - 32 : sub - 40), g = gi >> 1, n = (gi & 1) * 64 + (t & 63);
                bf16_t* RM = (bf16_t*)(p.ws + (sub < 40 ? WS_BM : WS_CM)) + ((size_t)(lc * 4 + g) * 64) * 128 + n;
                const unsigned pw[4] = {pk.x, pk.y, pk.z, pk.w};
#pragma unroll
                for (int j = 0; j < 8; ++j) RM[(size_t)(l0 + j) * 128] = (bf16_t)((j & 1) ? (pw[j >> 1] >> 16) : (pw[j >> 1] & 0xffffu));
                if (sub < 40) *(u32x4*)((bf16_t*)(p.ws + WS_BT) + ((size_t)(lc * 4 + g) * 128 + n) * 64 + l0) = pk;
            }
            if ((sample || lc == 127) && l0 == 56) {
                float* o3 = sample ? p.out + O_CONVS + (size_t)sb * 3 * 3072 + col : p.out + O_CONVP + (size_t)half * 3 * 3072 + col;
                o3[0] = v[8]; o3[3072] = v[9]; o3[2 * 3072] = v[10]; }
        } else if (sub < 64) {
            const int ch0 = (sub - 48) * 64, grp = ch0 >> 8;
            if (grp == 0) pool_tile<2>(p, half, lc, ch0, t); else if (grp == 1) pool_tile<4>(p, half, lc, ch0, t); else if (grp == 2) pool_tile<8>(p, half, lc, ch0, t); else pool_tile<16>(p, half, lc, ch0, t);
        } else {
            if (t < 32) { const int h = t; const float bias = p.in[16][h], A = -__expf(p.in[17][h]); float cs = 0.f;
                const float* D = (const float*)(p.ws + WS_DTR); float* DT = (float*)(p.ws + WS_DTC) + ((size_t)lc * 32 + h) * 64; float* AC = (float*)(p.ws + WS_ACS) + ((size_t)lc * 32 + h) * 64;
                for (int l = 0; l < 64; ++l) { const float x = D[(size_t)(r0 + l) * 32 + h] + bias; const float dt = fmaxf(x, 0.f) + log1pf(__expf(-fabsf(x))); cs += dt * A; DT[l] = dt; AC[l] = cs; } }
        }
    }
}

__device__ __forceinline__ bf16x8 pack8(const float* v) { u32x4 w; w.x = cvt_pk_bf16(v[0], v[1]); w.y = cvt_pk_bf16(v[2], v[3]); w.z = cvt_pk_bf16(v[4], v[5]); w.w = cvt_pk_bf16(v[6], v[7]); return __builtin_bit_cast(bf16x8, w); }
template <bool FULL>
__device__ __forceinline__ void ssd_chunk(f32x4 (&H)[8], const unsigned char* ws, int lc, int h, int pw, int c16, int q, float dskip) {
    const int g = h >> 3;
    const float* AC = (const float*)(ws + WS_ACS) + ((size_t)lc * 32 + h) * 64; const float* DT = (const float*)(ws + WS_DTC) + ((size_t)lc * 32 + h) * 64;
    const bf16_t* XTp = (const bf16_t*)(ws + WS_XT) + (((size_t)lc * 32 + h) * 64 + pw + c16) * 64;
    float acs_k[16], dt_k[16];
#pragma unroll
    for (int kk = 0; kk < 2; ++kk) { const f32x4 a0 = *(const f32x4*)(AC + 32 * kk + 8 * q), a1 = *(const f32x4*)(AC + 32 * kk + 8 * q + 4), d0 = *(const f32x4*)(DT + 32 * kk + 8 * q), d1 = *(const f32x4*)(DT + 32 * kk + 8 * q + 4);
#pragma unroll
        for (int j = 0; j < 4; ++j) { acs_k[kk * 8 + j] = a0[j]; acs_k[kk * 8 + 4 + j] = a1[j]; dt_k[kk * 8 + j] = d0[j]; dt_k[kk * 8 + 4 + j] = d1[j]; } }
    const float acs63 = AC[63];
    bf16x8 xf[2];
#pragma unroll
    for (int kk = 0; kk < 2; ++kk) xf[kk] = *(const bf16x8*)(XTp + 32 * kk + 8 * q);
    if (FULL) {
        const bf16_t* CMp = (const bf16_t*)(ws + WS_CM) + ((size_t)(lc * 4 + g) * 64) * 128;
        const bf16_t* CBp = (const bf16_t*)(ws + WS_CB) + ((size_t)(lc * 4 + g) * 64) * 64;
        bf16_t* Y = (bf16_t*)(ws + WS_X);
        bf16x8 hf[4];
#pragma unroll
        for (int kk = 0; kk < 4; ++kk) { float tv[8];
#pragma unroll
            for (int j = 0; j < 4; ++j) { tv[j] = H[2 * kk][j]; tv[4 + j] = H[2 * kk + 1][j]; }
            hf[kk] = pack8(tv); }
#pragma unroll
        for (int lt = 0; lt < 4; ++lt) {
            f32x4 y = {0.f, 0.f, 0.f, 0.f};
            const bf16_t* crow = CMp + (size_t)(16 * lt + c16) * 128;
#pragma unroll
            for (int kk = 0; kk < 4; ++kk) { const bf16x4 c0 = *(const bf16x4*)(crow + 32 * kk + 4 * q), c1 = *(const bf16x4*)(crow + 32 * kk + 16 + 4 * q);
                bf16x8 cf; cf[0] = c0[0]; cf[1] = c0[1]; cf[2] = c0[2]; cf[3] = c0[3]; cf[4] = c1[0]; cf[5] = c1[1]; cf[6] = c1[2]; cf[7] = c1[3];
                y = __builtin_amdgcn_mfma_f32_16x16x32_bf16(cf, hf[kk], y, 0, 0, 0); }
            const f32x4 ad = *(const f32x4*)(AC + 16 * lt + 4 * q);
#pragma unroll
            for (int i = 0; i < 4; ++i) y[i] *= __expf(ad[i]);
            const float arow = AC[16 * lt + c16]; const int l = 16 * lt + c16;
#pragma unroll
            for (int kk = 0; kk < 2; ++kk) if (kk <= (lt >> 1)) {
                const bf16x8 cb = *(const bf16x8*)(CBp + (size_t)l * 64 + 32 * kk + 8 * q); float lm[8];
#pragma unroll
                for (int j = 0; j < 8; ++j) { const int s = 32 * kk + 8 * q + j; lm[j] = (s <= l) ? bf2f(cb[j]) * __expf(arow - acs_k[kk * 8 + j]) * dt_k[kk * 8 + j] : 0.f; }
                y = __builtin_amdgcn_mfma_f32_16x16x32_bf16(pack8(lm), xf[kk], y, 0, 0, 0); }
            const bf16x4 xd = *(const bf16x4*)(XTp + 16 * lt + 4 * q);
#pragma unroll
            for (int i = 0; i < 4; ++i) { const float yv = y[i] + dskip * bf2f(xd[i]);
                Y[(size_t)(lc * 64 + 16 * lt + 4 * q + i) * 2048 + h * 64 + pw + c16] = (bf16_t)(cvt_pk_bf16(yv, 0.f) & 0xffffu); }
        }
    }
    const float dec = __expf(acs63);
    bf16x8 xw[2];
#pragma unroll
    for (int kk = 0; kk < 2; ++kk) { float tv[8];
#pragma unroll
        for (int j = 0; j < 8; ++j) tv[j] = bf2f(xf[kk][j]) * dt_k[kk * 8 + j] * __expf(acs63 - acs_k[kk * 8 + j]);
        xw[kk] = pack8(tv); }
    const bf16_t* BTp = (const bf16_t*)(ws + WS_BT) + ((size_t)(lc * 4 + g) * 128) * 64;
#pragma unroll
    for (int nt = 0; nt < 8; ++nt) { H[nt] *= dec;
#pragma unroll
        for (int kk = 0; kk < 2; ++kk) { const bf16x8 bt = *(const bf16x8*)(BTp + (size_t)(16 * nt + c16) * 64 + 32 * kk + 8 * q);
            H[nt] = __builtin_amdgcn_mfma_f32_16x16x32_bf16(bt, xw[kk], H[nt], 0, 0, 0); } }
}
__device__ __forceinline__ void cb_item(const unsigned char* ws, int idx, int w4, int c16, int q) {
    const bf16_t* Bp = (const bf16_t*)(ws + WS_BM) + (size_t)idx * 64 * 128; const bf16_t* Cp = (const bf16_t*)(ws + WS_CM) + (size_t)idx * 64 * 128;
    bf16_t* O = (bf16_t*)(ws + WS_CB) + (size_t)idx * 64 * 64;
    const int lt = w4;
    bf16x8 cf[4];
#pragma unroll
    for (int kk = 0; kk < 4; ++kk) cf[kk] = *(const bf16x8*)(Cp + (size_t)(16 * lt + c16) * 128 + 32 * kk + 8 * q);
    for (int st = 0; st <= lt; ++st) { f32x4 d = {0.f, 0.f, 0.f, 0.f};
#pragma unroll
        for (int kk = 0; kk < 4; ++kk) { const bf16x8 bfr = *(const bf16x8*)(Bp + (size_t)(16 * st + c16) * 128 + 32 * kk + 8 * q); d = __builtin_amdgcn_mfma_f32_16x16x32_bf16(bfr, cf[kk], d, 0, 0, 0); }
        u32x2 o; o.x = cvt_pk_bf16(d[0], d[1]); o.y = cvt_pk_bf16(d[2], d[3]);
        *(u32x2*)(O + (size_t)(16 * lt + c16) * 64 + 16 * st + 4 * q) = o; }
}
__device__ __forceinline__ void mix1_quads(const Params& p, int half) {
    const int t_ = otid(), bid = obid(); const int wid = t_ >> 6, lane = t_ & 63, quad = wid >> 2, w4 = wid & 3, c16 = lane & 15, q = lane >> 4;
    for (int item = bid * 2 + quad; item < 480 + NCHK * 4; item += gridDim.x * 2) {
        if (item < 480) { const int k = item >> 5, h = item & 31, pw = w4 * 16;
            f32x4 H[8];
#pragma unroll
            for (int nt = 0; nt < 8; ++nt) H[nt] = (f32x4){0.f, 0.f, 0.f, 0.f};
#pragma unroll 1
            for (int c = 0; c < 8; ++c) ssd_chunk<false>(H, p.ws, 8 * k + c, h, pw, c16, q, 0.f);
            float* ST = (float*)(p.ws + WS_ST) + (((size_t)k * 32 + h) * 64 + pw + c16) * 128;
#pragma unroll
            for (int nt = 0; nt < 8; ++nt) *(f32x4*)(ST + 16 * nt + 4 * q) = H[nt];
        } else cb_item(p.ws, item - 480, w4, c16, q);
    }
}
__device__ __forceinline__ void passb(const Params& p) {
    const int vb = gridDim.x - 1 - obid(); const int t_ = otid();
    for (int v = vb * 512 + t_; v < 65536; v += gridDim.x * 512) {
        const int h = v >> 11; f32x4 carry = {0.f, 0.f, 0.f, 0.f};
        float* ST = (float*)(p.ws + WS_ST) + (size_t)v * 4; const float* AC = (const float*)(p.ws + WS_ACS);
        for (int k = 0; k < 15; ++k) { float a = 0.f;
#pragma unroll
            for (int c = 0; c < 8; ++c) a += AC[((size_t)(8 * k + c) * 32 + h) * 64 + 63];
            const f32x4 s = *(const f32x4*)(ST + (size_t)k * 262144); carry = carry * __expf(a) + s; *(f32x4*)(ST + (size_t)k * 262144) = carry; }
    }
}
__device__ __forceinline__ void passc(const Params& p, int half) {
    const int t_ = otid(), bid = obid(); const int wid = t_ >> 6, lane = t_ & 63, quad = wid >> 2, w4 = wid & 3, c16 = lane & 15, q = lane >> 4, pw = w4 * 16;
    for (int item = bid * 2 + quad; item < 1024; item += gridDim.x * 2) {
        const int h = item & 31; const float dskip = p.in[18][h];
        f32x4 H[8];
        if (item < 512) { const int k = item >> 5;
            if (k == 0) {
#pragma unroll
                for (int nt = 0; nt < 8; ++nt) H[nt] = (f32x4){0.f, 0.f, 0.f, 0.f};
            } else { const float* ST = (const float*)(p.ws + WS_ST) + (((size_t)(k - 1) * 32 + h) * 64 + pw + c16) * 128;
#pragma unroll
                for (int nt = 0; nt < 8; ++nt) H[nt] = *(const f32x4*)(ST + 16 * nt + 4 * q); }
#pragma unroll 1
            for (int c = 0; c < 8; ++c) ssd_chunk<true>(H, p.ws, 8 * k + c, h, pw, c16, q, dskip);
            if (k == 15) { float* O = p.out + O_SSMP + (((size_t)half * 32 + h) * 64 + pw + c16) * 128;
#pragma unroll
                for (int nt = 0; nt < 8; ++nt) *(f32x4*)(O + 16 * nt + 4 * q) = H[nt]; }
        } else { const int sbl = (item - 512) >> 5, sb = 16 * half + sbl;
            const float* S0 = p.in[6] + (((size_t)sb * 32 + h) * 64 + pw + c16) * 128;
#pragma unroll
            for (int nt = 0; nt < 8; ++nt) H[nt] = *(const f32x4*)(S0 + 16 * nt + 4 * q);
            ssd_chunk<true>(H, p.ws, 128 + sbl, h, pw, c16, q, dskip);
            float* O = p.out + O_SSMS + (((size_t)sb * 32 + h) * 64 + pw + c16) * 128;
#pragma unroll
            for (int nt = 0; nt < 8; ++nt) *(f32x4*)(O + 16 * nt + 4 * q) = H[nt]; }
    }
}
__device__ __forceinline__ void s5_phase(const Params& p) {
    const int t_ = otid(), bid = obid(); const int lane = t_ & 63, wv = t_ >> 6;
    for (int r = bid * 8 + wv; r < HR; r += gridDim.x * 8) {
        bf16_t* Y = (bf16_t*)(p.ws + WS_X) + (size_t)r * 2048; const bf16_t* Z = (const bf16_t*)(p.ws + WS_Z) + (size_t)r * 2048;
#pragma unroll
        for (int g = 0; g < 4; ++g) { const int c = g * 512 + lane * 8;
            const u32x4 yv = *(const u32x4*)(Y + c), zv = *(const u32x4*)(Z + c);
            const unsigned yw[4] = {yv.x, yv.y, yv.z, yv.w}, zw[4] = {zv.x, zv.y, zv.z, zv.w};
            float v[8]; float ss = 0.f;
#pragma unroll
            for (int j = 0; j < 4; ++j) { v[2 * j] = bflo(yw[j]) * siluf_(bflo(zw[j])); v[2 * j + 1] = bfhi(yw[j]) * siluf_(bfhi(zw[j])); ss += v[2 * j] * v[2 * j] + v[2 * j + 1] * v[2 * j + 1]; }
            ss = wave_sum(ss);
            const float rstd = rsqrtf(ss * (1.0f / 512.0f) + 1e-6f);
            const f32x4 w0 = *(const f32x4*)(p.in[19] + c), w1 = *(const f32x4*)(p.in[19] + c + 4);
            u32x4 o; o.x = cvt_pk_bf16(v[0] * rstd * w0[0], v[1] * rstd * w0[1]); o.y = cvt_pk_bf16(v[2] * rstd * w0[2], v[3] * rstd * w0[3]);
            o.z = cvt_pk_bf16(v[4] * rstd * w1[0], v[5] * rstd * w1[1]); o.w = cvt_pk_bf16(v[6] * rstd * w1[2], v[7] * rstd * w1[3]);
            *(u32x4*)(Y + c) = o; }
    }
}

__device__ __forceinline__ void g_in(const Params& p, int half, LAS unsigned char* lds) { unsigned char* ws = p.ws; pg8::StaticOrder S;
    pg8::Gemm g{(const bf16_t*)(ws + WS_H), (const bf16_t*)(ws + WS_WIN), HR, NINP, 1024, 1024, 1024, 0}; S.init(HR, NINP, gridDim.x, obid());
    EpiIn E{ws, p.out, half}; pg8::gemm_phase(lds, g, S, E); }
__device__ __forceinline__ void g_pool(const Params& p, int half, LAS unsigned char* lds) { unsigned char* ws = p.ws; pg8::StaticOrder S;
    pg8::Gemm g{(const bf16_t*)(ws + WS_H), (const bf16_t*)(ws + WS_WGRP), HR, 1024, 256, 1024, 256, 256}; S.init(HR, 1024, gridDim.x, obid());
    EpiPool E{(bf16_t*)(ws + WS_AM), p.in[13]}; pg8::gemm_phase(lds, g, S, E); }
__device__ __forceinline__ void g_a(const Params& p, int half, LAS unsigned char* lds) { unsigned char* ws = p.ws; pg8::StaticOrder S;
    pg8::Gemm g{(const bf16_t*)(ws + WS_AM), (const bf16_t*)(ws + WS_WA), HR, 1024, 1024, 1024, 1024, 0}; S.init(HR, 1024, gridDim.x, obid());
    EpiA E{(bf16_t*)(ws + WS_H), (const bf16_t*)p.out + 1024, half}; pg8::gemm_phase(lds, g, S, E); }
__device__ __forceinline__ void g_b(const Params& p, int half, LAS unsigned char* lds) { unsigned char* ws = p.ws; pg8::StaticOrder S;
    pg8::Gemm g{(const bf16_t*)(ws + WS_X), (const bf16_t*)(ws + WS_WB), HR, 1024, 2048, 2048, 2048, 0}; S.init(HR, 1024, gridDim.x, obid());
    EpiB E{(bf16_t*)(ws + WS_GB), (const bf16_t*)(ws + WS_H)}; pg8::gemm_phase(lds, g, S, E); }
__device__ __forceinline__ void g_out(const Params& p, int half, LAS unsigned char* lds) { unsigned char* ws = p.ws; pg8::StaticOrder S;
    pg8::Gemm g{(const bf16_t*)(ws + WS_GB), (const bf16_t*)(ws + WS_WOUT), HR, 1024, 1024, 1024, 1024, 0}; S.init(HR, 1024, gridDim.x, obid());
    EpiRes E{p.out, p.in[0], p.in[1], (const float*)(ws + WS_MOD), 2048, half, 0}; pg8::gemm_phase(lds, g, S, E); }
__device__ __forceinline__ void g_f1(const Params& p, int half, LAS unsigned char* lds) { unsigned char* ws = p.ws; pg8::StaticOrder S;
    pg8::Gemm g{(const bf16_t*)(ws + WS_H), (const bf16_t*)(ws + WS_WF1), HR, 5632, 1024, 1024, 1024, 0}; S.init(HR, 5632, gridDim.x, obid());
    EpiF1 E{(bf16_t*)(ws + WS_X)}; pg8::gemm_phase(lds, g, S, E); }
__device__ __forceinline__ void g_f2(const Params& p, int half, LAS unsigned char* lds) { unsigned char* ws = p.ws; pg8::StaticOrder S;
    pg8::Gemm g{(const bf16_t*)(ws + WS_X), (const bf16_t*)(ws + WS_WF2), HR, 1024, DFF, DFF, DFF, 0}; S.init(HR, 1024, gridDim.x, obid());
    EpiRes E{p.out, p.in[0], p.in[1], (const float*)(ws + WS_MOD), 5120, half, 1}; pg8::gemm_phase(lds, g, S, E); }

__global__ void __launch_bounds__(512, 2) mega(Params p) {
    extern __shared__ __attribute__((aligned(16))) unsigned char shm[];
    LAS unsigned char* lds = (LAS unsigned char*)shm;
    for (int ph = p.ph_lo; ph < p.ph_hi; ++ph) {
        if (ph > p.ph_lo) { if (ph != 14) cg::this_grid().sync(); else __syncthreads(); }
        if (ph == 0) { phase0(p, (float*)shm); continue; }
        if (ph == 27) {
            const size_t i0 = (size_t)obid() * 512 + otid(), st = (size_t)gridDim.x * 512;
            if (DIAG_K < 0) { for (size_t i = i0; i < (size_t)28622848; i += st) { const float v = p.out[i]; if (!(fabsf(v) < 1e30f)) p.out[i] = 0.f; } }
            else {
                for (size_t i = i0; i < (size_t)18874368; i += st) { float a = 0.f;
#define DBF(off, n) { const float v = bf2f((short)((const bf16_t*)(p.ws + (off)))[i % (size_t)(n)]); a += (fabsf(v) < 1e30f) ? v : 777.f; }
#define DF32(off, n) { const float v = ((const float*)(p.ws + (off)))[i % (size_t)(n)]; a += (fabsf(v) < 1e30f) ? v : 777.f; }
                    DF32(WS_MOD, 34 * 6144)
                    if (DIAG_K == 0) { DBF(WS_H, HR * 1024) DBF(WS_WIN, NINP * 1024) DBF(WS_WGRP, 1024 * 256) DBF(WS_WA, 1024 * 1024) DBF(WS_WB, 2048 * 1024) DBF(WS_WOUT, 1024 * 1024) DBF(WS_WF1, 5632 * 1024) DBF(WS_WF2, 2816 * 1024) }
                    if (DIAG_K == 1) { DBF(WS_H, HR * 1024) DBF(WS_Z, HR * 2048) DBF(WS_X, HR * 3072) DBF(WS_GB, HR * 1024) DF32(WS_DTR, HR * 32) }
                    if (DIAG_K == 2) { DBF(WS_H, HR * 1024) DBF(WS_XT, HR * 2048) DBF(WS_BT, NCHK * 4 * 128 * 64) DBF(WS_CM, NCHK * 4 * 128 * 64) DBF(WS_BM, NCHK * 4 * 128 * 64) DF32(WS_DTC, HR * 32) DF32(WS_ACS, HR * 32) }
                    if (DIAG_K == 3) { DBF(WS_AM, HR * 1024) DF32(WS_ST, 15 * 32 * 64 * 128) }
                    if (DIAG_K == 4) { DBF(WS_H, HR * 1024) DF32(WS_ST, 15 * 32 * 64 * 128) }
                    if (DIAG_K == 5 || DIAG_K == 6) { DBF(WS_X, HR * 2048) }
                    if (DIAG_K == 7) { DBF(WS_GB, HR * 1024) }
                    p.out[i] = a; }
                if (DIAG_K < 5) for (size_t i = i0; i < (size_t)524288; i += st) p.out[O_SSMP + i] = 0.f;
                if (DIAG_K < 5) for (size_t i = i0; i < (size_t)8388608; i += st) p.out[O_SSMS + i] = 0.f;
                if (DIAG_K < 2) for (size_t i = i0; i < (size_t)(O_SSMP - O_POOLP); i += st) p.out[O_POOLP + i] = 0.f;
                if (DIAG_K < 2) for (size_t i = i0; i < (size_t)(O_SSMS - O_POOLS); i += st) p.out[O_POOLS + i] = 0.f;
            }
            continue; }
        const int half = (ph - 1) / 13, sp = (ph - 1) % 13;
        if (DIAG_K >= 0 && sp > DIAG_K) continue;
        switch (sp) {
        case 0: norm_phase<0>(p, half); break;
        case 1: g_in(p, half, lds); break;
        case 2: s1_phase(p, half); break;
        case 3: g_pool(p, half, lds); mix1_quads(p, half); break;
        case 4: g_a(p, half, lds); passb(p); break;
        case 5: passc(p, half); break;
        case 6: s5_phase(p); break;
        case 7: g_b(p, half, lds); break;
        case 8: g_out(p, half, lds); break;
        case 9: norm_phase<1>(p, half); break;
        case 10: g_f1(p, half, lds); break;
        case 11: g_f2(p, half, lds); break;
        default: norm_phase<2>(p, half); break;
        }
    }
}

extern "C" void kernel_launch(void* const* d_in, const int* in_sizes, int n_in, void* d_out, int out_size, void* d_ws, size_t ws_size, hipStream_t stream) {
    static int grid = 0;
    if (grid == 0) {
        int dev = 0, cus = 0, per_cu = 0;
        (void)hipGetDevice(&dev);
        (void)hipDeviceGetAttribute(&cus, hipDeviceAttributeMultiprocessorCount, dev);
        if (hipFuncSetAttribute((const void*)mega, hipFuncAttributeMaxDynamicSharedMemorySize, LDS_BYTES) != hipSuccess) { fprintf(stderr, "hipFuncSetAttribute failed\n"); grid = -1; return; }
        if (hipOccupancyMaxActiveBlocksPerMultiprocessor(&per_cu, (const void*)mega, 512, LDS_BYTES) != hipSuccess || per_cu < 1) { fprintf(stderr, "occupancy query failed (%d)\n", per_cu); (void)hipGetLastError(); per_cu = 1; }
        grid = cus * 1;
        if (ws_size < WS_END) { fprintf(stderr, "workspace too small: %zu < %zu\n", ws_size, (size_t)WS_END); grid = -1; return; }
    }
    if (grid < 0) return;
    Params p{};
    for (int i = 0; i < 27; ++i) p.in[i] = (const float*)d_in[i];
    p.out = (float*)d_out; p.ws = (unsigned char*)d_ws;
#if MULTI_LAUNCH
    for (int ph = 0; ph < NPHASE; ++ph) { p.ph_lo = ph; p.ph_hi = ph + 1; hipLaunchKernelGGL(mega, dim3(grid), dim3(512), LDS_BYTES, stream, p); }
#else
    p.ph_lo = 0; p.ph_hi = NPHASE;
    void* args[] = {&p};
    hipError_t e = hipLaunchCooperativeKernel((const void*)mega, dim3(grid), dim3(512), args, LDS_BYTES, stream);
    if (e != hipSuccess) fprintf(stderr, "cooperative launch failed: %s (grid %d)\n", hipGetErrorString(e), grid);
#endif
}
```

```cpp
#include <hip/hip_runtime.h>
#include <hip/hip_cooperative_groups.h>
#include <cstdio>
namespace cg = cooperative_groups;

#ifndef MULTI_LAUNCH
#define MULTI_LAUNCH 0
#endif

#define LAS __attribute__((address_space(3)))
typedef unsigned short bf16_t;
typedef short bf16x8 __attribute__((ext_vector_type(8)));
typedef short bf16x4 __attribute__((ext_vector_type(4)));
typedef float f32x4 __attribute__((ext_vector_type(4)));
typedef float f32x2 __attribute__((ext_vector_type(2)));
typedef unsigned u32x4 __attribute__((ext_vector_type(4)));
typedef unsigned u32x2 __attribute__((ext_vector_type(2)));

constexpr int DM = 1024, HR = 9216  , NCHK = 144  ;
constexpr int NH = 32, DFF = 2816, NIN = 8224, NINP = 8448;
constexpr int LDS_BYTES = 131072;
#ifndef REPEAT_SP
#define REPEAT_SP -1
#endif
#ifndef DIAG_K
#define DIAG_K -1
#endif
#ifndef SANITIZE
#define SANITIZE 0
#endif
constexpr int NPHASE = 27 + SANITIZE;

constexpr size_t WS_WIN = 0;
constexpr size_t WS_WGRP = WS_WIN + (size_t)NINP * 1024 * 2;
constexpr size_t WS_WA = WS_WGRP + (size_t)1024 * 256 * 2;
constexpr size_t WS_WB = WS_WA + (size_t)1024 * 1024 * 2;
constexpr size_t WS_WOUT = WS_WB + (size_t)1024 * 2048 * 2;
constexpr size_t WS_WF1 = WS_WOUT + (size_t)1024 * 1024 * 2;
constexpr size_t WS_WF2 = WS_WF1 + (size_t)5632 * 1024 * 2;
constexpr size_t WS_MOD = WS_WF2 + (size_t)1024 * 2816 * 2;
constexpr size_t WS_H = WS_MOD + (size_t)34 * 6144 * 4;
constexpr size_t WS_Z = WS_H + (size_t)HR * 1024 * 2;
constexpr size_t WS_X = WS_Z + (size_t)HR * 2048 * 2;
constexpr size_t WS_AM = WS_X + (size_t)HR * 2048 * 2;
constexpr size_t WS_GB = WS_X + (size_t)HR * 3072 * 2;
constexpr size_t WS_XT = WS_GB + (size_t)HR * 1024 * 2;
constexpr size_t WS_BT = WS_XT + (size_t)HR * 2048 * 2;
constexpr size_t WS_CM = WS_BT + (size_t)NCHK * 4 * 128 * 64 * 2;
constexpr size_t WS_BM = WS_CM + (size_t)NCHK * 4 * 128 * 64 * 2;
constexpr size_t WS_CB = WS_BM + (size_t)NCHK * 4 * 128 * 64 * 2;
constexpr size_t WS_ST = WS_CB + (size_t)NCHK * 4 * 64 * 64 * 2;
constexpr size_t WS_DTR = WS_ST + (size_t)15 * 32 * 64 * 128 * 4;
constexpr size_t WS_DTC = WS_DTR + (size_t)HR * 32 * 4;
constexpr size_t WS_ACS = WS_DTC + (size_t)HR * 32 * 4;
constexpr size_t WS_END = WS_ACS + (size_t)HR * 32 * 4;
static_assert(WS_END <= (size_t)256 * 1024 * 1024, "workspace");

constexpr size_t O_Y = 0;
constexpr size_t O_POOLP = 18874368;
constexpr size_t O_CONVP = O_POOLP + 30720;
constexpr size_t O_SSMP = O_CONVP + 18432;
constexpr size_t O_POOLS = O_SSMP + 524288;
constexpr size_t O_CONVS = O_POOLS + 491520;
constexpr size_t O_SSMS = O_CONVS + 294912;

struct Params {
    const float* in[27];
    float* out;
    unsigned char* ws;
    int ph_lo, ph_hi;
};

typedef __bf16 bfx2_t __attribute__((ext_vector_type(2)));
__device__ __forceinline__ unsigned cvt_pk_bf16(float lo, float hi) { const f32x2 v = {lo, hi}; return __builtin_bit_cast(unsigned, __builtin_convertvector(v, bfx2_t)); }
__device__ __forceinline__ float bf2f(short b) { return __uint_as_float(((unsigned)(unsigned short)b) << 16); }
__device__ __forceinline__ float bflo(unsigned w) { return __uint_as_float(w << 16); }
__device__ __forceinline__ float bfhi(unsigned w) { return __uint_as_float(w & 0xffff0000u); }
__device__ __forceinline__ float sigmoidf_(float x) { return 1.0f / (1.0f + __expf(-x)); }
__device__ __forceinline__ float siluf_(float x) { return x / (1.0f + __expf(-x)); }
__device__ __forceinline__ int segoff(int half, int pm) { return pm < 32 ? half * 8192 : 8192 + half * 1024; }
__device__ __forceinline__ int gtok(int half, int r) { return r + (r < 8192 ? half * 8192 : 8192 + half * 1024); }
__device__ __forceinline__ int modrow(int half, int r) { return r < 8192 ? half : 2 + 16 * half + ((r - 8192) >> 6); }
__device__ __forceinline__ int otid() { int t = threadIdx.x; asm volatile("" : "+v"(t)); return t; }
__device__ __forceinline__ int obid() { int b = blockIdx.x; asm volatile("" : "+s"(b)); return b; }
__device__ __forceinline__ float wave_sum(float v) {
#pragma unroll
    for (int o = 32; o > 0; o >>= 1) v += __shfl_xor(v, o, 64);
    return v;
}

namespace pg8 {
constexpr int BM = 256, BK = 64, HALF = 128, HTB = HALF * BK * 2, STAGE_BYTES = 8 * HTB, NXCD = 8, WGM = 8;
__device__ __forceinline__ int lds_byte(int r, int c) { const int st = (r >> 4) * 2 + (c >> 5), rr = r & 15, cc = c & 31, ob = rr * 64 + cc * 2; return st * 1024 + (ob ^ (((ob >> 9) & 1) << 5)); }
__device__ __forceinline__ void stage_rc(int b, int& R, int& C) { const int st = b / 1024, sb = b % 1024, swz = sb ^ (((sb >> 9) & 1) << 5); R = (st >> 1) * 16 + swz / 64; C = (st & 1) * 32 + (swz % 64) / 2; }
__device__ __forceinline__ int perm32(int rho) { const int n = rho >> 4, i = rho & 15; return 8 * (i >> 2) + 4 * n + (i & 3); }
struct Unit { int pm, pn; };
struct Gemm { const bf16_t* A; const bf16_t* Bt; int M, N, K, lda, ldb, acoff; };
struct StaticOrder {
    int nM, nN, nwg, G, c;
    __device__ void init(int M, int N, int G_, int c_) { nM = M / BM; nN = N / BM; nwg = nM * nN; G = G_; c = c_; }
    __device__ bool next(int i, Unit& u) const {
        const long L = (long)i * G + c; if (L >= nwg) return false;
        int wgid = (int)L; { const int q = nwg / NXCD, r = nwg % NXCD, xcd = wgid % NXCD, off = wgid / NXCD; wgid = (xcd < r ? xcd * (q + 1) : r * (q + 1) + (xcd - r) * q) + off; }
        const int nig = WGM * nN, gid = wgid / nig, fm = gid * WGM, gsz = (nM - fm) < WGM ? (nM - fm) : WGM;
        u.pm = fm + ((wgid % nig) % gsz); u.pn = (wgid % nig) / gsz; return true;
    }
};

template <class Epi>
__device__ __forceinline__ void gemm_phase(LAS unsigned char* lds, const Gemm g, const StaticOrder& S, const Epi& E) {
    const int tid = otid(), wid = __builtin_amdgcn_readfirstlane(tid >> 6), lane = tid & 63, wr = wid >> 2, wc = wid & 3, fr = lane & 15, fq = lane >> 4;
    const int nt = g.K / BK;
    unsigned voffA[2], voffB[2];
#pragma unroll
    for (int i = 0; i < 2; ++i) { int R, C; stage_rc(tid * 16 + i * 8192, R, C); const int Rb = Epi::PERM ? ((R & ~31) + perm32(R & 31)) : R;
        voffA[i] = (unsigned)(R * g.lda + C) * 2u; voffB[i] = (unsigned)(Rb * g.ldb + C) * 2u; }
    const size_t kstep = (size_t)(BK * 2);
    const size_t hstepA = (size_t)HALF * g.lda * 2, hstepB = (size_t)HALF * g.ldb * 2;
    const size_t tstepA = 2 * hstepA, tstepB = 2 * hstepB;
    const unsigned ldsw = (unsigned)wid * 1024u;
    const int aoff = lds_byte(wr * 64 + fr, fq * 8), boff = lds_byte(wc * 32 + fr, fq * 8);
#define PG8_SA(b, h) (((b) * 2 + (h)) * HTB)
#define PG8_SB(b, h) ((4 + (b) * 2 + (h)) * HTB)
#define PG8_STAGE(bufoff, gbase, voff) do { _Pragma("unroll") for (int _i = 0; _i < 2; ++_i) \
        __builtin_amdgcn_global_load_lds((const unsigned*)((const char*)(gbase) + (voff)[_i]), (LAS unsigned*)(lds + (bufoff) + ldsw + _i * 8192), 16, 0, 0); } while (0)
#define PG8_LDA(dst, b, h) do { _Pragma("unroll") for (int m = 0; m < 4; ++m) _Pragma("unroll") for (int k = 0; k < 2; ++k) dst[m][k] = *(const LAS bf16x8*)(lds + PG8_SA(b, h) + aoff + m * 2048 + k * 1024); } while (0)
#define PG8_LDB(dst, b, h) do { _Pragma("unroll") for (int n = 0; n < 2; ++n) _Pragma("unroll") for (int k = 0; k < 2; ++k) dst[n][k] = *(const LAS bf16x8*)(lds + PG8_SB(b, h) + boff + n * 2048 + k * 1024); } while (0)
#define PG8_MMA(ai, bj, At, Bt) do { __builtin_amdgcn_s_setprio(1); _Pragma("unroll") for (int m = 0; m < 4; ++m) _Pragma("unroll") for (int n = 0; n < 2; ++n) _Pragma("unroll") for (int k = 0; k < 2; ++k) \
        acc[ai][bj][m][n] = __builtin_amdgcn_mfma_f32_16x16x32_bf16(Bt[n][k], At[m][k], acc[ai][bj][m][n], 0, 0, 0); __builtin_amdgcn_s_setprio(0); } while (0)
#define PG8_WAIT_V(n) asm volatile("s_waitcnt vmcnt(" #n ")" ::: "memory")
#define PG8_WAIT_L(n) asm volatile("s_waitcnt lgkmcnt(" #n ")" ::: "memory")
#define PG8_BAR __builtin_amdgcn_s_barrier()
#define PG8_SCHED __builtin_amdgcn_sched_barrier(0)
    Unit cur, nxt; int ui = 0;
    if (!S.next(0, cur)) return;
    f32x4 acc[2][2][4][2];
#pragma unroll
    for (int a = 0; a < 2; ++a)
#pragma unroll
        for (int b = 0; b < 2; ++b)
#pragma unroll
            for (int m = 0; m < 4; ++m)
#pragma unroll
                for (int n = 0; n < 2; ++n) acc[a][b][m][n] = (f32x4){0.f, 0.f, 0.f, 0.f};
    bf16x8 At[4][2], B0[2][2], B1[2][2];
    const char* cA = (const char*)g.A + (size_t)cur.pm * tstepA + (size_t)cur.pn * g.acoff * 2; const char* cB = (const char*)g.Bt + (size_t)cur.pn * tstepB;
    PG8_STAGE(PG8_SB(0, 0), cB, voffB); PG8_STAGE(PG8_SA(0, 0), cA, voffA); PG8_STAGE(PG8_SB(0, 1), cB + hstepB, voffB); PG8_STAGE(PG8_SA(0, 1), cA + hstepA, voffA);
    if (wr == 1) PG8_BAR;
    PG8_WAIT_V(4); PG8_BAR;
    PG8_STAGE(PG8_SB(1, 0), cB + kstep, voffB); PG8_STAGE(PG8_SA(1, 0), cA + kstep, voffA); PG8_STAGE(PG8_SB(1, 1), cB + hstepB + kstep, voffB);
    PG8_WAIT_V(6); PG8_BAR;
    for (;;) {
        const bool has_next = S.next(ui + 1, nxt);
        const char* nA = has_next ? (const char*)g.A + (size_t)nxt.pm * tstepA + (size_t)nxt.pn * g.acoff * 2 : cA; const char* nB = has_next ? (const char*)g.Bt + (size_t)nxt.pn * tstepB : cB;
#pragma unroll 1
        for (int t = 0; t < nt; t += 2) {
            const bool last = (t == nt - 2);
            const char* a1 = cA + (size_t)(t + 1) * kstep;
            const char* a2 = last ? nA : cA + (size_t)(t + 2) * kstep; const char* b2 = last ? nB : cB + (size_t)(t + 2) * kstep;
            const char* a3 = a2 + kstep; const char* b3 = b2 + kstep;
            PG8_LDB(B0, 0, 0); PG8_SCHED; PG8_LDA(At, 0, 0); PG8_STAGE(PG8_SA(1, 1), a1 + hstepA, voffA);
            PG8_WAIT_L(8); PG8_BAR; PG8_WAIT_L(0); PG8_MMA(0, 0, At, B0); PG8_BAR; PG8_SCHED;
            PG8_LDB(B1, 0, 1); PG8_STAGE(PG8_SB(0, 0), b2, voffB);
            PG8_BAR; PG8_WAIT_L(0); PG8_MMA(0, 1, At, B1); PG8_BAR;
            PG8_LDA(At, 0, 1); PG8_STAGE(PG8_SA(0, 0), a2, voffA);
            PG8_BAR; PG8_WAIT_L(0); PG8_MMA(1, 0, At, B0); PG8_BAR; PG8_SCHED;
            PG8_STAGE(PG8_SB(0, 1), b2 + hstepB, voffB);
            PG8_WAIT_V(6); PG8_BAR; PG8_MMA(1, 1, At, B1); PG8_BAR;
            PG8_LDB(B0, 1, 0); PG8_SCHED; PG8_LDA(At, 1, 0); PG8_STAGE(PG8_SA(0, 1), a2 + hstepA, voffA);
            PG8_WAIT_L(8); PG8_BAR; PG8_WAIT_L(0); PG8_MMA(0, 0, At, B0); PG8_BAR; PG8_SCHED;
            PG8_LDB(B1, 1, 1); PG8_STAGE(PG8_SB(1, 0), b3, voffB);
            PG8_BAR; PG8_WAIT_L(0); PG8_MMA(0, 1, At, B1); PG8_BAR;
            PG8_LDA(At, 1, 1); PG8_STAGE(PG8_SA(1, 0), a3, voffA);
            PG8_BAR; PG8_WAIT_L(0); PG8_MMA(1, 0, At, B0); PG8_BAR; PG8_SCHED;
            PG8_STAGE(PG8_SB(1, 1), b3 + hstepB, voffB);
            PG8_WAIT_V(6); PG8_BAR; PG8_MMA(1, 1, At, B1); PG8_BAR;
        }
        E(acc, cur, wr, wc, fr, fq);
        if (!has_next) break;
#pragma unroll
        for (int a = 0; a < 2; ++a)
#pragma unroll
            for (int b = 0; b < 2; ++b)
#pragma unroll
                for (int m = 0; m < 4; ++m)
#pragma unroll
                    for (int n = 0; n < 2; ++n) acc[a][b][m][n] = (f32x4){0.f, 0.f, 0.f, 0.f};
        cur = nxt; cA = nA; cB = nB; ++ui;
    }
    PG8_WAIT_V(0);
    if (wr == 0) PG8_BAR;
    PG8_BAR;
#undef PG8_SA
#undef PG8_SB
#undef PG8_STAGE
#undef PG8_LDA
#undef PG8_LDB
#undef PG8_MMA
#undef PG8_WAIT_V
#undef PG8_WAIT_L
#undef PG8_BAR
#undef PG8_SCHED
}
}
using pg8::Unit;
typedef f32x4 AccT[2][2][4][2];

struct EpiIn {
    static constexpr bool PERM = true;
    unsigned char* ws; float* out; int half;
    __device__ __forceinline__ void operator()(const AccT& acc, const Unit& u, int wr, int wc, int fr, int fq) const {
        const int pn = u.pn; const int row0 = u.pm * 256 + wr * 64 + fr;
        if (pn == 32) {
            if (wc == 0) { float* D = (float*)(ws + WS_DTR);
#pragma unroll
                for (int ai = 0; ai < 2; ++ai)
#pragma unroll
                    for (int m = 0; m < 4; ++m) { const int r = row0 + ai * 128 + m * 16;
                        *(f32x4*)(D + (size_t)r * 32 + 8 * fq) = acc[ai][0][m][0]; *(f32x4*)(D + (size_t)r * 32 + 8 * fq + 4) = acc[ai][0][m][1]; } }
            return; }
        bf16_t* base; int ld, radd = 0, c0; bool sig = false;
        if (pn < 4) { base = (bf16_t*)out; ld = 2048; radd = segoff(half, u.pm); c0 = pn * 256; }
        else if (pn < 12) { base = (bf16_t*)(ws + WS_Z); ld = 2048; c0 = (pn - 4) * 256; }
        else if (pn < 24) { base = (bf16_t*)(ws + WS_X); ld = 3072; c0 = (pn - 12) * 256; }
        else if (pn < 28) { base = (bf16_t*)out + 1024; ld = 2048; radd = segoff(half, u.pm); c0 = (pn - 24) * 256; sig = true; }
        else { base = (bf16_t*)(ws + WS_GB); ld = 1024; c0 = (pn - 28) * 256; sig = true; }
        const int col0 = c0 + wc * 32 + 8 * fq;
#pragma unroll
        for (int ai = 0; ai < 2; ++ai)
#pragma unroll
            for (int m = 0; m < 4; ++m) { bf16_t* rowp = base + (size_t)(row0 + radd + ai * 128 + m * 16) * ld + col0;
#pragma unroll
                for (int bj = 0; bj < 2; ++bj) { f32x4 v0 = acc[ai][bj][m][0], v1 = acc[ai][bj][m][1];
                    if (sig) {
#pragma unroll
                        for (int j = 0; j < 4; ++j) { v0[j] = sigmoidf_(v0[j]); v1[j] = sigmoidf_(v1[j]); } }
                    u32x4 w; w.x = cvt_pk_bf16(v0[0], v0[1]); w.y = cvt_pk_bf16(v0[2], v0[3]); w.z = cvt_pk_bf16(v1[0], v1[1]); w.w = cvt_pk_bf16(v1[2], v1[3]);
                    *(u32x4*)(rowp + bj * 128) = w; } }
    }
};
struct EpiPool {
    static constexpr bool PERM = true;
    bf16_t* O; const float* scale;
    __device__ __forceinline__ void operator()(const AccT& acc, const Unit& u, int wr, int wc, int fr, int fq) const {
        const int row0 = u.pm * 256 + wr * 64 + fr, col0 = u.pn * 256 + wc * 32 + 8 * fq;
        f32x4 sv[2][2];
#pragma unroll
        for (int bj = 0; bj < 2; ++bj)
#pragma unroll
            for (int n = 0; n < 2; ++n) sv[bj][n] = *(const f32x4*)(scale + col0 + bj * 128 + 4 * n);
#pragma unroll
        for (int ai = 0; ai < 2; ++ai)
#pragma unroll
            for (int m = 0; m < 4; ++m) { bf16_t* rowp = O + (size_t)(row0 + ai * 128 + m * 16) * 1024 + col0;
#pragma unroll
                for (int bj = 0; bj < 2; ++bj) { f32x4 v0 = acc[ai][bj][m][0] * sv[bj][0], v1 = acc[ai][bj][m][1] * sv[bj][1];
                    u32x4 w; w.x = cvt_pk_bf16(v0[0], v0[1]); w.y = cvt_pk_bf16(v0[2], v0[3]); w.z = cvt_pk_bf16(v1[0], v1[1]); w.w = cvt_pk_bf16(v1[2], v1[3]);
                    *(u32x4*)(rowp + bj * 128) = w; } }
    }
};
struct EpiA {
    static constexpr bool PERM = true;
    bf16_t* O; const bf16_t* GA  ; int half;
    __device__ __forceinline__ void operator()(const AccT& acc, const Unit& u, int wr, int wc, int fr, int fq) const {
        const int row0 = u.pm * 256 + wr * 64 + fr, col0 = u.pn * 256 + wc * 32 + 8 * fq, radd = segoff(half, u.pm);
#pragma unroll
        for (int ai = 0; ai < 2; ++ai)
#pragma unroll
            for (int m = 0; m < 4; ++m) { const int r = row0 + ai * 128 + m * 16; bf16_t* rowp = O + (size_t)r * 1024 + col0; const bf16_t* gp = GA + (size_t)(r + radd) * 2048 + col0;
#pragma unroll
                for (int bj = 0; bj < 2; ++bj) { const u32x4 gv = *(const u32x4*)(gp + bj * 128); const f32x4 v0 = acc[ai][bj][m][0], v1 = acc[ai][bj][m][1];
                    u32x4 w; w.x = cvt_pk_bf16(v0[0] * bflo(gv.x), v0[1] * bfhi(gv.x)); w.y = cvt_pk_bf16(v0[2] * bflo(gv.y), v0[3] * bfhi(gv.y));
                    w.z = cvt_pk_bf16(v1[0] * bflo(gv.z), v1[1] * bfhi(gv.z)); w.w = cvt_pk_bf16(v1[2] * bflo(gv.w), v1[3] * bfhi(gv.w));
                    *(u32x4*)(rowp + bj * 128) = w; } }
    }
};
struct EpiB {
    static constexpr bool PERM = true;
    bf16_t* GBM; const bf16_t* MA;
    __device__ __forceinline__ void operator()(const AccT& acc, const Unit& u, int wr, int wc, int fr, int fq) const {
        const int row0 = u.pm * 256 + wr * 64 + fr, col0 = u.pn * 256 + wc * 32 + 8 * fq;
#pragma unroll
        for (int ai = 0; ai < 2; ++ai)
#pragma unroll
            for (int m = 0; m < 4; ++m) { const size_t ro = (size_t)(row0 + ai * 128 + m * 16) * 1024 + col0;
#pragma unroll
                for (int bj = 0; bj < 2; ++bj) { const u32x4 gv = *(const u32x4*)(GBM + ro + bj * 128); const u32x4 av = *(const u32x4*)(MA + ro + bj * 128); const f32x4 v0 = acc[ai][bj][m][0], v1 = acc[ai][bj][m][1];
                    u32x4 w; w.x = cvt_pk_bf16(bflo(av.x) + v0[0] * bflo(gv.x), bfhi(av.x) + v0[1] * bfhi(gv.x)); w.y = cvt_pk_bf16(bflo(av.y) + v0[2] * bflo(gv.y), bfhi(av.y) + v0[3] * bfhi(gv.y));
                    w.z = cvt_pk_bf16(bflo(av.z) + v1[0] * bflo(gv.z), bfhi(av.z) + v1[1] * bfhi(gv.z)); w.w = cvt_pk_bf16(bflo(av.w) + v1[2] * bflo(gv.w), bfhi(av.w) + v1[3] * bfhi(gv.w));
                    *(u32x4*)(GBM + ro + bj * 128) = w; } }
    }
};
struct EpiRes {
    static constexpr bool PERM = false;
    float* dst; const float* xp; const float* xs; const float* mod; int goff; int half; int inplace;
    __device__ __forceinline__ void operator()(const AccT& acc, const Unit& u, int wr, int wc, int fr, int fq) const {
        const int row0 = u.pm * 256 + wr * 64 + fr, col0 = u.pn * 256 + wc * 32 + 4 * fq;
#pragma unroll
        for (int ai = 0; ai < 2; ++ai)
#pragma unroll
            for (int m = 0; m < 4; ++m) { const int r = row0 + ai * 128 + m * 16; const int gt = gtok(half, r);
                float* dp = dst + (size_t)gt * 1024 + col0;
                const float* sp = inplace ? dp : (r < 8192 ? xp + (size_t)(half * 8192 + r) * 1024 + col0 : xs + (size_t)(half * 1024 + r - 8192) * 1024 + col0);
                const float* gp = mod + (size_t)modrow(half, r) * 6144 + goff + col0;
#pragma unroll
                for (int bj = 0; bj < 2; ++bj)
#pragma unroll
                    for (int n = 0; n < 2; ++n) { const int o = bj * 128 + n * 16; const f32x4 s = *(const f32x4*)(sp + o), gg = *(const f32x4*)(gp + o);
                        *(f32x4*)(dp + o) = s + gg * acc[ai][bj][m][n]; } }
    }
};
struct EpiF1 {
    static constexpr bool PERM = false;
    bf16_t* O;
    __device__ __forceinline__ void operator()(const AccT& acc, const Unit& u, int wr, int wc, int fr, int fq) const {
        const int row0 = u.pm * 256 + wr * 64 + fr, col0 = u.pn * 128 + wc * 16 + 4 * fq;
#pragma unroll
        for (int ai = 0; ai < 2; ++ai)
#pragma unroll
            for (int m = 0; m < 4; ++m) { bf16_t* rowp = O + (size_t)(row0 + ai * 128 + m * 16) * DFF + col0;
#pragma unroll
                for (int bj = 0; bj < 2; ++bj) { const f32x4 a = acc[ai][bj][m][0], b = acc[ai][bj][m][1];
                    u32x2 w; w.x = cvt_pk_bf16(siluf_(a[0]) * b[0], siluf_(a[1]) * b[1]); w.y = cvt_pk_bf16(siluf_(a[2]) * b[2], siluf_(a[3]) * b[3]);
                    *(u32x2*)(rowp + bj * 64) = w; } }
    }
};

__device__ __forceinline__ const float* wsrc(const Params& p, int w, int r, int& ld) {
    switch (w) {
    case 0: { ld = NIN; const float* b = p.in[11]; if (r < 6144) return b + r; if (r < 8192) return b + r + 32; if (r < 8224) return b + 6144 + (r - 8192); return nullptr; }
    case 1: ld = 256; return p.in[12] + (size_t)(r >> 8) * 65536 + (r & 255);
    case 2: ld = 1024; return p.in[20] + r;
    case 3: ld = 1024; return p.in[21] + r;
    case 4: ld = 1024; return p.in[22] + r;
    case 5: { ld = DFF; const int pn = r >> 8, bj = (r >> 7) & 1, wc = (r >> 5) & 3, n = (r >> 4) & 1, fq = (r >> 2) & 3, e = r & 3; const int G = pn * 128 + bj * 64 + wc * 16 + fq * 4 + e; return (n ? p.in[24] : p.in[23]) + G; }
    default: ld = 1024; return p.in[25] + r;
    }
}
__device__ __forceinline__ void phase0(const Params& p, float* lds) {
    const int t = otid(), bid = obid();
    const int total_tiles = 2112 + 64 + 256 + 512 + 256 + 1408 + 704;
    for (int item = bid; item < 96 + total_tiles; item += gridDim.x) {
        if (item < 96) {
            const int slab = item, jc = t & 63, kg = t >> 6;
            float acc[34];
#pragma unroll
            for (int b = 0; b < 34; ++b) acc[b] = 0.f;
            for (int kh = 0; kh < 2; ++kh) {
                __syncthreads();
                for (int o = t; o < 34 * 512; o += 512) { const int b = o >> 9, kk = o & 511; const float cv = (b < 2 ? p.in[2] + b * 1024 : p.in[3] + (b - 2) * 1024)[kh * 512 + kk]; lds[o] = siluf_(cv); }
                __syncthreads();
                for (int kk = kg * 64; kk < kg * 64 + 64; ++kk) { const float wv = p.in[7][(size_t)(kh * 512 + kk) * 6144 + slab * 64 + jc];
#pragma unroll
                    for (int b = 0; b < 34; ++b) acc[b] += lds[b * 512 + kk] * wv; }
            }
            __syncthreads();
#pragma unroll
            for (int b = 0; b < 34; ++b) lds[(kg * 34 + b) * 64 + jc] = acc[b];
            __syncthreads();
            for (int o = t; o < 34 * 64; o += 512) { const int b = o >> 6, j = o & 63; float s = 0.f;
#pragma unroll
                for (int k8 = 0; k8 < 8; ++k8) s += lds[(k8 * 34 + b) * 64 + j];
                ((float*)(p.ws + WS_MOD))[b * 6144 + slab * 64 + j] = s + p.in[8][slab * 64 + j]; }
            __syncthreads();
        } else {
            int ti = item - 96, w, ktw; size_t wow;
            if (ti < 2112) { w = 0; ktw = 16; wow = WS_WIN; }
            else if ((ti -= 2112) < 64) { w = 1; ktw = 4; wow = WS_WGRP; }
            else if ((ti -= 64) < 256) { w = 2; ktw = 16; wow = WS_WA; }
            else if ((ti -= 256) < 512) { w = 3; ktw = 32; wow = WS_WB; }
            else if ((ti -= 512) < 256) { w = 4; ktw = 16; wow = WS_WOUT; }
            else if ((ti -= 256) < 1408) { w = 5; ktw = 16; wow = WS_WF1; }
            else { ti -= 1408; w = 6; ktw = 44; wow = WS_WF2; }
            const int K = ktw * 64, r0 = (ti / ktw) * 64, k0 = (ti % ktw) * 64;
            { const int rr = t & 63, kq = t >> 6; int ld; const float* sp = wsrc(p, w, r0 + rr, ld);
#pragma unroll
                for (int i = 0; i < 8; ++i) { const int kl = kq + 8 * i; lds[kl * 65 + rr] = sp ? sp[(size_t)(k0 + kl) * ld] : 0.f; } }
            __syncthreads();
            { const int ro = t >> 3, kk = (t & 7) * 8; float v[8];
#pragma unroll
                for (int j = 0; j < 8; ++j) v[j] = lds[(kk + j) * 65 + ro];
                u32x4 o; o.x = cvt_pk_bf16(v[0], v[1]); o.y = cvt_pk_bf16(v[2], v[3]); o.z = cvt_pk_bf16(v[4], v[5]); o.w = cvt_pk_bf16(v[6], v[7]);
                *(u32x4*)((bf16_t*)(p.ws + wow) + (size_t)(r0 + ro) * K + k0 + kk) = o; }
            __syncthreads();
        }
    }
}

template <int MODE>
__device__ __forceinline__ void norm_phase(const Params& p, int half) {
    const int t_ = otid(), bid = obid(); const int lane = t_ & 63, wv = t_ >> 6;
    const float* w = MODE == 0 ? p.in[9] : (MODE == 1 ? p.in[10] : p.in[26]);
    f32x4 wq[4];
#pragma unroll
    for (int i = 0; i < 4; ++i) wq[i] = *(const f32x4*)(w + i * 256 + lane * 4);
    for (int r = bid * 8 + wv; r < HR; r += gridDim.x * 8) {
        const float* src;
        if (MODE == 0) src = r < 8192 ? p.in[0] + (size_t)(half * 8192 + r) * 1024 : p.in[1] + (size_t)(half * 1024 + r - 8192) * 1024;
        else src = p.out + (size_t)gtok(half, r) * 1024;
        f32x4 v[4]; float ss = 0.f;
#pragma unroll
        for (int i = 0; i < 4; ++i) { v[i] = *(const f32x4*)(src + i * 256 + lane * 4); ss += v[i][0] * v[i][0] + v[i][1] * v[i][1] + v[i][2] * v[i][2] + v[i][3] * v[i][3]; }
        ss = wave_sum(ss);
        const float rstd = rsqrtf(ss * (1.0f / 1024.0f) + 1e-6f);
        if (MODE == 2) {
            float* dst = p.out + (size_t)gtok(half, r) * 1024;
#pragma unroll
            for (int i = 0; i < 4; ++i) *(f32x4*)(dst + i * 256 + lane * 4) = v[i] * rstd * wq[i];
        } else {
            const float* mr = (const float*)(p.ws + WS_MOD) + (size_t)modrow(half, r) * 6144 + (MODE == 0 ? 0 : 3072);
            bf16_t* dst = (bf16_t*)(p.ws + WS_H) + (size_t)r * 1024;
#pragma unroll
            for (int i = 0; i < 4; ++i) { const f32x4 sh = *(const f32x4*)(mr + i * 256 + lane * 4), sc = *(const f32x4*)(mr + 1024 + i * 256 + lane * 4);
                const f32x4 y = (v[i] * rstd * wq[i]) * (sc + 1.0f) + sh;
                u32x2 o; o.x = cvt_pk_bf16(y[0], y[1]); o.y = cvt_pk_bf16(y[2], y[3]); *(u32x2*)(dst + i * 256 + lane * 4) = o; }
        }
    }
}

template <int W>
__device__ __forceinline__ void pool_pass(const Params& p, int half, int lc, int grp, int lg, int lane) {
    const int ch = grp * 256 + lane * 4, l0 = lg * 8;
    const bool sample = lc >= 128, first = sample || lc == 0;
    const int sb = 16 * half + lc - 128;
    const int r0 = lc * 64, radd = sample ? 8192 + half * 1024 : half * 8192;
    const bf16_t* Pb = (const bf16_t*)p.out + (size_t)(r0 + l0 + radd) * 2048 + ch;
    float v[23][4];
#pragma unroll
    for (int i = 0; i < 23; ++i) { const int l = l0 - 15 + i;
        if (l >= 0 || !first) { const u32x2 w = *(const u32x2*)(Pb + (ptrdiff_t)(i - 15) * 2048); v[i][0] = bflo(w.x); v[i][1] = bfhi(w.x); v[i][2] = bflo(w.y); v[i][3] = bfhi(w.y); }
        else if (sample) { const f32x4 f = *(const f32x4*)(p.in[4] + ((size_t)sb * 15 + 15 + l) * 1024 + ch); v[i][0] = f[0]; v[i][1] = f[1]; v[i][2] = f[2]; v[i][3] = f[3]; }
        else { v[i][0] = v[i][1] = v[i][2] = v[i][3] = 0.f; } }
    float S[4] = {0.f, 0.f, 0.f, 0.f};
#pragma unroll
    for (int j = 0; j < W; ++j)
#pragma unroll
        for (int c = 0; c < 4; ++c) S[c] += v[15 - j][c];
    bf16_t* M = (bf16_t*)(p.ws + WS_H);
#pragma unroll
    for (int i = 0; i < 8; ++i) {
        if (i > 0) {
#pragma unroll
            for (int c = 0; c < 4; ++c) S[c] += v[15 + i][c] - v[15 + i - W][c]; }
        const int l = l0 + i; const int pos1 = sample ? 4097 + l : r0 + l + 1;
        const float rc = 1.0f / (float)(pos1 < W ? pos1 : W);
        u32x2 o; o.x = cvt_pk_bf16(S[0] * rc - v[15 + i][0], S[1] * rc - v[15 + i][1]); o.y = cvt_pk_bf16(S[2] * rc - v[15 + i][2], S[3] * rc - v[15 + i][3]);
        *(u32x2*)(M + (size_t)(r0 + l) * 1024 + ch) = o;
        if ((sample || lc == 127) && l >= 49) {
            float* op = sample ? p.out + O_POOLS + ((size_t)sb * 15 + (l - 49)) * 1024 + ch : p.out + O_POOLP + ((size_t)half * 15 + (l - 49)) * 1024 + ch;
            *(f32x4*)op = (f32x4){v[15 + i][0], v[15 + i][1], v[15 + i][2], v[15 + i][3]}; }
    }
}
__device__ __forceinline__ void s1_phase(const Params& p, int half, float* lds) {
    const int t0_ = otid(), bid = obid(); const int wid = __builtin_amdgcn_readfirstlane(t0_ >> 6);
    for (int item = bid; item < NCHK * 11; item += gridDim.x) {
        int t = t0_; asm volatile("" : "+v"(t)); const int lane = t & 63;
        const int lc = item / 11, sub = item % 11;
        const bool sample = lc >= 128, first = sample || lc == 0;
        const int sb = 16 * half + lc - 128;
        const int r0 = lc * 64;
        if (sub < 6) {
            const int lg = wid, l0 = lg * 8, col = sub * 512 + lane * 8;
            const bf16_t* Xb = (const bf16_t*)(p.ws + WS_X) + (size_t)(r0 + l0) * 3072 + col;
            float v[11][8];
#pragma unroll
            for (int i = 0; i < 11; ++i) { const int l = l0 - 3 + i;
                if (l >= 0 || !first) { const u32x4 w = *(const u32x4*)(Xb + (ptrdiff_t)(i - 3) * 3072);
                    v[i][0] = bflo(w.x); v[i][1] = bfhi(w.x); v[i][2] = bflo(w.y); v[i][3] = bfhi(w.y); v[i][4] = bflo(w.z); v[i][5] = bfhi(w.z); v[i][6] = bflo(w.w); v[i][7] = bfhi(w.w); }
                else if (sample) { const float* hp = p.in[5] + ((size_t)sb * 3 + 3 + l) * 3072 + col; const f32x4 f0 = *(const f32x4*)hp, f1 = *(const f32x4*)(hp + 4);
#pragma unroll
                    for (int c = 0; c < 4; ++c) { v[i][c] = f0[c]; v[i][4 + c] = f1[c]; } }
                else {
#pragma unroll
                    for (int c = 0; c < 8; ++c) v[i][c] = 0.f; } }
            if ((sample || lc == 127) && lg == 7) {
                float* o3 = sample ? p.out + O_CONVS + (size_t)sb * 3 * 3072 + col : p.out + O_CONVP + (size_t)half * 3 * 3072 + col;
#pragma unroll
                for (int k = 0; k < 3; ++k) { *(f32x4*)(o3 + (size_t)k * 3072) = (f32x4){v[8 + k][0], v[8 + k][1], v[8 + k][2], v[8 + k][3]}; *(f32x4*)(o3 + (size_t)k * 3072 + 4) = (f32x4){v[8 + k][4], v[8 + k][5], v[8 + k][6], v[8 + k][7]}; } }
            float wk[4][8], cbv[8];
#pragma unroll
            for (int k = 0; k < 4; ++k) { const f32x4 a0 = *(const f32x4*)(p.in[14] + (size_t)k * 3072 + col), a1 = *(const f32x4*)(p.in[14] + (size_t)k * 3072 + col + 4);
#pragma unroll
                for (int c = 0; c < 4; ++c) { wk[k][c] = a0[c]; wk[k][4 + c] = a1[c]; } }
            { const f32x4 a0 = *(const f32x4*)(p.in[15] + col), a1 = *(const f32x4*)(p.in[15] + col + 4);
#pragma unroll
                for (int c = 0; c < 4; ++c) { cbv[c] = a0[c]; cbv[4 + c] = a1[c]; } }
#pragma unroll
            for (int li = 0; li < 8; ++li)
#pragma unroll
                for (int c = 0; c < 8; ++c) v[li][c] = siluf_(cbv[c] + wk[0][c] * v[li][c] + wk[1][c] * v[li + 1][c] + wk[2][c] * v[li + 2][c] + wk[3][c] * v[li + 3][c]);
            if (sub >= 4) {
                const int ncol = col - (sub == 4 ? 2048 : 2560), g = ncol >> 7, n = ncol & 127;
                bf16_t* RM = (bf16_t*)(p.ws + (sub == 4 ? WS_BM : WS_CM)) + ((size_t)(lc * 4 + g) * 64 + l0) * 128 + n;
#pragma unroll
                for (int li = 0; li < 8; ++li) { u32x4 o; o.x = cvt_pk_bf16(v[li][0], v[li][1]); o.y = cvt_pk_bf16(v[li][2], v[li][3]); o.z = cvt_pk_bf16(v[li][4], v[li][5]); o.w = cvt_pk_bf16(v[li][6], v[li][7]);
                    *(u32x4*)(RM + (size_t)li * 128) = o; } }
            if (sub <= 4) {
                bf16_t* TB;
                if (sub < 4) { const int head = col >> 6, pp = col & 63; TB = (bf16_t*)(p.ws + WS_XT) + (((size_t)lc * 32 + head) * 64 + pp) * 64 + l0; }
                else { const int ncol = col - 2048, g = ncol >> 7, n = ncol & 127; TB = (bf16_t*)(p.ws + WS_BT) + ((size_t)(lc * 4 + g) * 128 + n) * 64 + l0; }
#pragma unroll
                for (int c = 0; c < 8; ++c) { u32x4 o; o.x = cvt_pk_bf16(v[0][c], v[1][c]); o.y = cvt_pk_bf16(v[2][c], v[3][c]); o.z = cvt_pk_bf16(v[4][c], v[5][c]); o.w = cvt_pk_bf16(v[6][c], v[7][c]);
                    *(u32x4*)(TB + (size_t)c * 64) = o; } }
        } else if (sub < 10) {
            const int grp = sub - 6;
            if (grp == 0) pool_pass<2>(p, half, lc, grp, wid, lane); else if (grp == 1) pool_pass<4>(p, half, lc, grp, wid, lane); else if (grp == 2) pool_pass<8>(p, half, lc, grp, wid, lane); else pool_pass<16>(p, half, lc, grp, wid, lane);
        } else {
            const int h = t & 31, lq = t >> 5;
            const float bias = p.in[16][h], A = -__expf(p.in[17][h]);
            const float* D = (const float*)(p.ws + WS_DTR);
            float dt[4], cs[4]; float run = 0.f;
#pragma unroll
            for (int j = 0; j < 4; ++j) { const float x = D[(size_t)(r0 + lq * 4 + j) * 32 + h] + bias; dt[j] = fmaxf(x, 0.f) + log1pf(__expf(-fabsf(x))); run += dt[j] * A; cs[j] = run; }
            __syncthreads();
            lds[lq * 32 + h] = run;
            __syncthreads();
            float base = 0.f;
            for (int k = 0; k < lq; ++k) base += lds[k * 32 + h];
            float* DT = (float*)(p.ws + WS_DTC) + ((size_t)lc * 32 + h) * 64 + lq * 4; float* AC = (float*)(p.ws + WS_ACS) + ((size_t)lc * 32 + h) * 64 + lq * 4;
            *(f32x4*)DT = (f32x4){dt[0], dt[1], dt[2], dt[3]}; *(f32x4*)AC = (f32x4){base + cs[0], base + cs[1], base + cs[2], base + cs[3]};
        }
    }
}

__device__ __forceinline__ bf16x8 pack8(const float* v) { u32x4 w; w.x = cvt_pk_bf16(v[0], v[1]); w.y = cvt_pk_bf16(v[2], v[3]); w.z = cvt_pk_bf16(v[4], v[5]); w.w = cvt_pk_bf16(v[6], v[7]); return __builtin_bit_cast(bf16x8, w); }
constexpr int SL_CM = 0, SL_CB = 64 * 272, SL_BT = SL_CB + 64 * 144, SL_AD = SL_BT + 128 * 144, SL_SIZE = SL_AD + 1024;
struct StageRegs { u32x4 r[5]; u32x4 ad; };
template <bool FULL>
__device__ __forceinline__ void stage_load(StageRegs& R, const unsigned char* ws, int lc, int g, int h0, int t) {
    if (FULL) {
        const u32x4* cm = (const u32x4*)(ws + WS_CM + (size_t)(lc * 4 + g) * 16384); R.r[0] = cm[t]; R.r[1] = cm[t + 512];
        R.r[2] = ((const u32x4*)(ws + WS_CB + (size_t)(lc * 4 + g) * 8192))[t]; }
    const u32x4* bt = (const u32x4*)(ws + WS_BT + (size_t)(lc * 4 + g) * 16384); R.r[3] = bt[t]; R.r[4] = bt[t + 512];
    if (t < 64) { const int e = t >> 5, part = (t >> 4) & 1, c = t & 15; R.ad = *(const u32x4*)(ws + (part ? WS_DTC : WS_ACS) + ((size_t)(lc * 32 + h0 + e) * 64) * 4 + c * 16); }
}
template <bool FULL>
__device__ __forceinline__ void stage_store(const StageRegs& R, LAS unsigned char* B, int t) {
    if (FULL) {
        *(LAS u32x4*)(B + SL_CM + (t >> 4) * 272 + (t & 15) * 16) = R.r[0]; *(LAS u32x4*)(B + SL_CM + (32 + (t >> 4)) * 272 + (t & 15) * 16) = R.r[1];
        *(LAS u32x4*)(B + SL_CB + (t >> 3) * 144 + (t & 7) * 16) = R.r[2]; }
    *(LAS u32x4*)(B + SL_BT + (t >> 3) * 144 + (t & 7) * 16) = R.r[3]; *(LAS u32x4*)(B + SL_BT + (64 + (t >> 3)) * 144 + (t & 7) * 16) = R.r[4];
    if (t < 64) *(LAS u32x4*)(B + SL_AD + t * 16) = R.ad;
}
struct XtRegs { bf16x8 xf[2]; bf16x4 xd[4]; };
template <bool FULL>
__device__ __forceinline__ void xt_load(XtRegs& X, const unsigned char* ws, int lc, int h, int pw, int c16, int q) {
    const bf16_t* XTp = (const bf16_t*)(ws + WS_XT) + (((size_t)lc * 32 + h) * 64 + pw + c16) * 64;
    X.xf[0] = *(const bf16x8*)(XTp + 8 * q); X.xf[1] = *(const bf16x8*)(XTp + 32 + 8 * q);
    if (FULL) {
#pragma unroll
        for (int lt = 0; lt < 4; ++lt) X.xd[lt] = *(const bf16x4*)(XTp + 16 * lt + 4 * q); }
}
template <bool FULL>
__device__ __forceinline__ void ssd_step(f32x4 (&H)[8], LAS unsigned char* B, int hsel, const XtRegs& X, unsigned char* ws, int lc, int h, int pw, int c16, int q, float dskip) {
    LAS unsigned char* AD = B + SL_AD + hsel * 512;
    float acs_k[16], dt_k[16];
#pragma unroll
    for (int kk = 0; kk < 2; ++kk) { const f32x4 a0 = *(LAS f32x4*)(AD + (32 * kk + 8 * q) * 4), a1 = *(LAS f32x4*)(AD + (32 * kk + 8 * q + 4) * 4), d0 = *(LAS f32x4*)(AD + 256 + (32 * kk + 8 * q) * 4), d1 = *(LAS f32x4*)(AD + 256 + (32 * kk + 8 * q + 4) * 4);
#pragma unroll
        for (int j = 0; j < 4; ++j) { acs_k[kk * 8 + j] = a0[j]; acs_k[kk * 8 + 4 + j] = a1[j]; dt_k[kk * 8 + j] = d0[j]; dt_k[kk * 8 + 4 + j] = d1[j]; } }
    const float acs63 = *(LAS float*)(AD + 63 * 4);
    if (FULL) {
        bf16_t* Y = (bf16_t*)(ws + WS_X);
        bf16x8 hf[4];
#pragma unroll
        for (int kk = 0; kk < 4; ++kk) { float tv[8];
#pragma unroll
            for (int j = 0; j < 4; ++j) { tv[j] = H[2 * kk][j]; tv[4 + j] = H[2 * kk + 1][j]; }
            hf[kk] = pack8(tv); }
#pragma unroll
        for (int lt = 0; lt < 4; ++lt) {
            const int l = 16 * lt + c16;
            bf16x8 cf[4], cb[2];
#pragma unroll
            for (int kk = 0; kk < 4; ++kk) cf[kk] = *(LAS bf16x8*)(B + SL_CM + l * 272 + (32 * kk + 8 * q) * 2);
#pragma unroll
            for (int kk = 0; kk < 2; ++kk) if (kk <= (lt >> 1)) cb[kk] = *(LAS bf16x8*)(B + SL_CB + l * 144 + (32 * kk + 8 * q) * 2);
            const f32x4 ad = *(LAS f32x4*)(AD + (16 * lt + 4 * q) * 4);
            const float arow = *(LAS float*)(AD + l * 4);
            f32x4 y = {0.f, 0.f, 0.f, 0.f};
#pragma unroll
            for (int kk = 0; kk < 4; ++kk) y = __builtin_amdgcn_mfma_f32_16x16x32_bf16(cf[kk], hf[kk], y, 0, 0, 0);
#pragma unroll
            for (int i = 0; i < 4; ++i) y[i] *= __expf(ad[i]);
#pragma unroll
            for (int kk = 0; kk < 2; ++kk) if (kk <= (lt >> 1)) { float lm[8];
#pragma unroll
                for (int j = 0; j < 8; ++j) { const int s_ = 32 * kk + 8 * q + j; lm[j] = (s_ <= l) ? bf2f(cb[kk][j]) * __expf(arow - acs_k[kk * 8 + j]) * dt_k[kk * 8 + j] : 0.f; }
                y = __builtin_amdgcn_mfma_f32_16x16x32_bf16(pack8(lm), X.xf[kk], y, 0, 0, 0); }
#pragma unroll
            for (int i = 0; i < 4; ++i) { const float yv = y[i] + dskip * bf2f(X.xd[lt][i]);
                Y[(size_t)(lc * 64 + 16 * lt + 4 * q + i) * 2048 + h * 64 + pw + c16] = (bf16_t)(cvt_pk_bf16(yv, 0.f) & 0xffffu); }
        }
    }
    const float dec = __expf(acs63);
    bf16x8 xw[2];
#pragma unroll
    for (int kk = 0; kk < 2; ++kk) { float tv[8];
#pragma unroll
        for (int j = 0; j < 8; ++j) tv[j] = bf2f(X.xf[kk][j]) * dt_k[kk * 8 + j] * __expf(acs63 - acs_k[kk * 8 + j]);
        xw[kk] = pack8(tv); }
    const int nlane = 8 * (c16 >> 2) + (c16 & 3);
#pragma unroll
    for (int np = 0; np < 4; ++np) {
        bf16x8 bt[2][2];
#pragma unroll
        for (int e = 0; e < 2; ++e)
#pragma unroll
            for (int kk = 0; kk < 2; ++kk) bt[e][kk] = *(LAS bf16x8*)(B + SL_BT + (32 * np + nlane + 4 * e) * 144 + (32 * kk + 8 * q) * 2);
#pragma unroll
        for (int e = 0; e < 2; ++e) { H[2 * np + e] *= dec;
#pragma unroll
            for (int kk = 0; kk < 2; ++kk) H[2 * np + e] = __builtin_amdgcn_mfma_f32_16x16x32_bf16(bt[e][kk], xw[kk], H[2 * np + e], 0, 0, 0); } }
}
template <bool FULL>
__device__ __forceinline__ void ssd_walk(f32x4 (&H)[8], LAS unsigned char* lds, unsigned char* ws, int lc0, int nsteps, int h0, int t, int quad, int pw, int c16, int q, float dskip) {
    const int g = h0 >> 3, h = h0 + quad;
    StageRegs R; XtRegs Xn, X;
    stage_load<FULL>(R, ws, lc0, g, h0, t); xt_load<FULL>(Xn, ws, lc0, h, pw, c16, q);
    stage_store<FULL>(R, lds, t);
    __syncthreads();
#pragma unroll 1
    for (int c = 0; c < nsteps; ++c) {
        X = Xn;
        const bool more = c + 1 < nsteps;
        if (more) { stage_load<FULL>(R, ws, lc0 + c + 1, g, h0, t); xt_load<FULL>(Xn, ws, lc0 + c + 1, h, pw, c16, q); }
        ssd_step<FULL>(H, lds + (c & 1) * SL_SIZE, quad, X, ws, lc0 + c, h, pw, c16, q, dskip);
        if (more) stage_store<FULL>(R, lds + ((c + 1) & 1) * SL_SIZE, t);
        __syncthreads();
    }
}
__device__ __forceinline__ int n0_of(int nt, int q) { return 32 * (nt >> 1) + 8 * q + 4 * (nt & 1); }
__device__ __forceinline__ void cb_item(const unsigned char* ws, int idx, int w4, int c16, int q) {
    const bf16_t* Bp = (const bf16_t*)(ws + WS_BM) + (size_t)idx * 64 * 128; const bf16_t* Cp = (const bf16_t*)(ws + WS_CM) + (size_t)idx * 64 * 128;
    bf16_t* O = (bf16_t*)(ws + WS_CB) + (size_t)idx * 64 * 64;
    const int lt = w4;
    bf16x8 cf[4];
#pragma unroll
    for (int kk = 0; kk < 4; ++kk) cf[kk] = *(const bf16x8*)(Cp + (size_t)(16 * lt + c16) * 128 + 32 * kk + 8 * q);
    for (int st = 0; st <= lt; ++st) { f32x4 d = {0.f, 0.f, 0.f, 0.f};
#pragma unroll
        for (int kk = 0; kk < 4; ++kk) { const bf16x8 bfr = *(const bf16x8*)(Bp + (size_t)(16 * st + c16) * 128 + 32 * kk + 8 * q); d = __builtin_amdgcn_mfma_f32_16x16x32_bf16(bfr, cf[kk], d, 0, 0, 0); }
        u32x2 o; o.x = cvt_pk_bf16(d[0], d[1]); o.y = cvt_pk_bf16(d[2], d[3]);
        *(u32x2*)(O + (size_t)(16 * lt + c16) * 64 + 16 * st + 4 * q) = o; }
}
__device__ __forceinline__ void mix1_quads(const Params& p, int half, LAS unsigned char* lds) {
    const int t = otid(), bid = obid(); const int wid = __builtin_amdgcn_readfirstlane(t >> 6), lane = t & 63, quad = wid >> 2, w4 = wid & 3, c16 = lane & 15, q = lane >> 4, pw = w4 * 16;
    for (int item = bid; item < 240; item += gridDim.x) { const int k = item >> 4, h0 = (item & 15) * 2;
        f32x4 H[8];
#pragma unroll
        for (int nt = 0; nt < 8; ++nt) H[nt] = (f32x4){0.f, 0.f, 0.f, 0.f};
        ssd_walk<false>(H, lds, p.ws, 8 * k, 8, h0, t, quad, pw, c16, q, 0.f);
        float* ST = (float*)(p.ws + WS_ST) + (((size_t)k * 32 + h0 + quad) * 64 + pw + c16) * 128;
#pragma unroll
        for (int nt = 0; nt < 8; ++nt) *(f32x4*)(ST + n0_of(nt, q)) = H[nt];
    }
    for (int item = (gridDim.x - 1 - bid) * 2 + quad; item < NCHK * 4; item += gridDim.x * 2) cb_item(p.ws, item, w4, c16, q);
}
__device__ __forceinline__ void passb(const Params& p) {
    const int vb = gridDim.x - 1 - obid(); const int t_ = otid();
    for (int v = vb * 512 + t_; v < 65536; v += gridDim.x * 512) {
        const int h = v >> 11; f32x4 carry = {0.f, 0.f, 0.f, 0.f};
        float* ST = (float*)(p.ws + WS_ST) + (size_t)v * 4; const float* AC = (const float*)(p.ws + WS_ACS);
        for (int k = 0; k < 15; ++k) { float a = 0.f;
#pragma unroll
            for (int c = 0; c < 8; ++c) a += AC[((size_t)(8 * k + c) * 32 + h) * 64 + 63];
            const f32x4 s = *(const f32x4*)(ST + (size_t)k * 262144); carry = carry * __expf(a) + s; *(f32x4*)(ST + (size_t)k * 262144) = carry; }
    }
}
__device__ __forceinline__ void passc(const Params& p, int half, LAS unsigned char* lds) {
    const int t = otid(), bid = obid(); const int wid = __builtin_amdgcn_readfirstlane(t >> 6), lane = t & 63, quad = wid >> 2, w4 = wid & 3, c16 = lane & 15, q = lane >> 4, pw = w4 * 16;
    for (int item = bid; item < 256; item += gridDim.x) {
    const int h0 = (item & 15) * 2, h = h0 + quad; const float dskip = p.in[18][h];
    f32x4 H[8];
    { const int k = item >> 4;
        if (k == 0) {
#pragma unroll
            for (int nt = 0; nt < 8; ++nt) H[nt] = (f32x4){0.f, 0.f, 0.f, 0.f};
        } else { const float* ST = (const float*)(p.ws + WS_ST) + (((size_t)(k - 1) * 32 + h) * 64 + pw + c16) * 128;
#pragma unroll
            for (int nt = 0; nt < 8; ++nt) H[nt] = *(const f32x4*)(ST + n0_of(nt, q)); }
        ssd_walk<true>(H, lds, p.ws, 8 * k, 8, h0, t, quad, pw, c16, q, dskip);
        if (k == 15) { float* O = p.out + O_SSMP + (((size_t)half * 32 + h) * 64 + pw + c16) * 128;
#pragma unroll
            for (int nt = 0; nt < 8; ++nt) *(f32x4*)(O + n0_of(nt, q)) = H[nt]; } }
    { const int sbl = item >> 4, sb = 16 * half + sbl;
        const float* S0 = p.in[6] + (((size_t)sb * 32 + h) * 64 + pw + c16) * 128;
#pragma unroll
        for (int nt = 0; nt < 8; ++nt) H[nt] = *(const f32x4*)(S0 + n0_of(nt, q));
        ssd_walk<true>(H, lds, p.ws, 128 + sbl, 1, h0, t, quad, pw, c16, q, dskip);
        float* O = p.out + O_SSMS + (((size_t)sb * 32 + h) * 64 + pw + c16) * 128;
#pragma unroll
        for (int nt = 0; nt < 8; ++nt) *(f32x4*)(O + n0_of(nt, q)) = H[nt]; }
    }
}
__device__ __forceinline__ void s5_phase(const Params& p) {
    const int t_ = otid(), bid = obid(); const int lane = t_ & 63, wv = t_ >> 6;
    for (int r = bid * 8 + wv; r < HR; r += gridDim.x * 8) {
        bf16_t* Y = (bf16_t*)(p.ws + WS_X) + (size_t)r * 2048; const bf16_t* Z = (const bf16_t*)(p.ws + WS_Z) + (size_t)r * 2048;
#pragma unroll
        for (int g = 0; g < 4; ++g) { const int c = g * 512 + lane * 8;
            const u32x4 yv = *(const u32x4*)(Y + c), zv = *(const u32x4*)(Z + c);
            const unsigned yw[4] = {yv.x, yv.y, yv.z, yv.w}, zw[4] = {zv.x, zv.y, zv.z, zv.w};
            float v[8]; float ss = 0.f;
#pragma unroll
            for (int j = 0; j < 4; ++j) { v[2 * j] = bflo(yw[j]) * siluf_(bflo(zw[j])); v[2 * j + 1] = bfhi(yw[j]) * siluf_(bfhi(zw[j])); ss += v[2 * j] * v[2 * j] + v[2 * j + 1] * v[2 * j + 1]; }
            ss = wave_sum(ss);
            const float rstd = rsqrtf(ss * (1.0f / 512.0f) + 1e-6f);
            const f32x4 w0 = *(const f32x4*)(p.in[19] + c), w1 = *(const f32x4*)(p.in[19] + c + 4);
            u32x4 o; o.x = cvt_pk_bf16(v[0] * rstd * w0[0], v[1] * rstd * w0[1]); o.y = cvt_pk_bf16(v[2] * rstd * w0[2], v[3] * rstd * w0[3]);
            o.z = cvt_pk_bf16(v[4] * rstd * w1[0], v[5] * rstd * w1[1]); o.w = cvt_pk_bf16(v[6] * rstd * w1[2], v[7] * rstd * w1[3]);
            *(u32x4*)(Y + c) = o; }
    }
}

__device__ __forceinline__ void g_in(const Params& p, int half, LAS unsigned char* lds) { unsigned char* ws = p.ws; pg8::StaticOrder S;
    pg8::Gemm g{(const bf16_t*)(ws + WS_H), (const bf16_t*)(ws + WS_WIN), HR, NINP, 1024, 1024, 1024, 0}; S.init(HR, NINP, gridDim.x, obid());
    EpiIn E{ws, p.out, half}; pg8::gemm_phase(lds, g, S, E); }
__device__ __forceinline__ void g_pool(const Params& p, int half, LAS unsigned char* lds) { unsigned char* ws = p.ws; pg8::StaticOrder S;
    pg8::Gemm g{(const bf16_t*)(ws + WS_H), (const bf16_t*)(ws + WS_WGRP), HR, 1024, 256, 1024, 256, 256}; S.init(HR, 1024, gridDim.x, obid());
    EpiPool E{(bf16_t*)(ws + WS_AM), p.in[13]}; pg8::gemm_phase(lds, g, S, E); }
__device__ __forceinline__ void g_a(const Params& p, int half, LAS unsigned char* lds) { unsigned char* ws = p.ws; pg8::StaticOrder S;
    pg8::Gemm g{(const bf16_t*)(ws + WS_AM), (const bf16_t*)(ws + WS_WA), HR, 1024, 1024, 1024, 1024, 0}; S.init(HR, 1024, gridDim.x, obid());
    EpiA E{(bf16_t*)(ws + WS_H), (const bf16_t*)p.out + 1024, half}; pg8::gemm_phase(lds, g, S, E); }
__device__ __forceinline__ void g_b(const Params& p, int half, LAS unsigned char* lds) { unsigned char* ws = p.ws; pg8::StaticOrder S;
    pg8::Gemm g{(const bf16_t*)(ws + WS_X), (const bf16_t*)(ws + WS_WB), HR, 1024, 2048, 2048, 2048, 0}; S.init(HR, 1024, gridDim.x, obid());
    EpiB E{(bf16_t*)(ws + WS_GB), (const bf16_t*)(ws + WS_H)}; pg8::gemm_phase(lds, g, S, E); }
__device__ __forceinline__ void g_out(const Params& p, int half, LAS unsigned char* lds) { unsigned char* ws = p.ws; pg8::StaticOrder S;
    pg8::Gemm g{(const bf16_t*)(ws + WS_GB), (const bf16_t*)(ws + WS_WOUT), HR, 1024, 1024, 1024, 1024, 0}; S.init(HR, 1024, gridDim.x, obid());
    EpiRes E{p.out, p.in[0], p.in[1], (const float*)(ws + WS_MOD), 2048, half, 0}; pg8::gemm_phase(lds, g, S, E); }
__device__ __forceinline__ void g_f1(const Params& p, int half, LAS unsigned char* lds) { unsigned char* ws = p.ws; pg8::StaticOrder S;
    pg8::Gemm g{(const bf16_t*)(ws + WS_H), (const bf16_t*)(ws + WS_WF1), HR, 5632, 1024, 1024, 1024, 0}; S.init(HR, 5632, gridDim.x, obid());
    EpiF1 E{(bf16_t*)(ws + WS_X)}; pg8::gemm_phase(lds, g, S, E); }
__device__ __forceinline__ void g_f2(const Params& p, int half, LAS unsigned char* lds) { unsigned char* ws = p.ws; pg8::StaticOrder S;
    pg8::Gemm g{(const bf16_t*)(ws + WS_X), (const bf16_t*)(ws + WS_WF2), HR, 1024, DFF, DFF, DFF, 0}; S.init(HR, 1024, gridDim.x, obid());
    EpiRes E{p.out, p.in[0], p.in[1], (const float*)(ws + WS_MOD), 5120, half, 1}; pg8::gemm_phase(lds, g, S, E); }

__global__ void __launch_bounds__(512, 2) mega(Params p) {
    extern __shared__ __attribute__((aligned(16))) unsigned char shm[];
    LAS unsigned char* lds = (LAS unsigned char*)shm;
    for (int ph = p.ph_lo; ph < p.ph_hi; ++ph) {
        if (ph > p.ph_lo) { if (ph != 14) cg::this_grid().sync(); else __syncthreads(); }
        if (ph == 0) { phase0(p, (float*)shm); if (REPEAT_SP == 100) { __syncthreads(); phase0(p, (float*)shm); } continue; }
        if (ph == 27) {
            const size_t i0 = (size_t)obid() * 512 + otid(), st = (size_t)gridDim.x * 512;
            if (DIAG_K < 0) { for (size_t i = i0; i < (size_t)28622848; i += st) { const float v = p.out[i]; if (!(fabsf(v) < 1e30f)) p.out[i] = 0.f; } }
            else {
                for (size_t i = i0; i < (size_t)18874368; i += st) { float a = 0.f;
#define DBF(off, n) { const float v = bf2f((short)((const bf16_t*)(p.ws + (off)))[i % (size_t)(n)]); a += (fabsf(v) < 1e30f) ? v : 777.f; }
#define DF32(off, n) { const float v = ((const float*)(p.ws + (off)))[i % (size_t)(n)]; a += (fabsf(v) < 1e30f) ? v : 777.f; }
                    DF32(WS_MOD, 34 * 6144)
                    if (DIAG_K == 0) { DBF(WS_H, HR * 1024) DBF(WS_WIN, NINP * 1024) DBF(WS_WGRP, 1024 * 256) DBF(WS_WA, 1024 * 1024) DBF(WS_WB, 2048 * 1024) DBF(WS_WOUT, 1024 * 1024) DBF(WS_WF1, 5632 * 1024) DBF(WS_WF2, 2816 * 1024) }
                    if (DIAG_K == 1) { DBF(WS_H, HR * 1024) DBF(WS_Z, HR * 2048) DBF(WS_X, HR * 3072) DBF(WS_GB, HR * 1024) DF32(WS_DTR, HR * 32) }
                    if (DIAG_K == 2) { DBF(WS_H, HR * 1024) DBF(WS_XT, HR * 2048) DBF(WS_BT, NCHK * 4 * 128 * 64) DBF(WS_CM, NCHK * 4 * 128 * 64) DBF(WS_BM, NCHK * 4 * 128 * 64) DF32(WS_DTC, HR * 32) DF32(WS_ACS, HR * 32) }
                    if (DIAG_K == 3) { DBF(WS_AM, HR * 1024) DF32(WS_ST, 15 * 32 * 64 * 128) }
                    if (DIAG_K == 4) { DBF(WS_H, HR * 1024) DF32(WS_ST, 15 * 32 * 64 * 128) }
                    if (DIAG_K == 5 || DIAG_K == 6) { DBF(WS_X, HR * 2048) }
                    if (DIAG_K == 7) { DBF(WS_GB, HR * 1024) }
                    p.out[i] = a; }
                if (DIAG_K < 5) for (size_t i = i0; i < (size_t)524288; i += st) p.out[O_SSMP + i] = 0.f;
                if (DIAG_K < 5) for (size_t i = i0; i < (size_t)8388608; i += st) p.out[O_SSMS + i] = 0.f;
                if (DIAG_K < 2) for (size_t i = i0; i < (size_t)(O_SSMP - O_POOLP); i += st) p.out[O_POOLP + i] = 0.f;
                if (DIAG_K < 2) for (size_t i = i0; i < (size_t)(O_SSMS - O_POOLS); i += st) p.out[O_POOLS + i] = 0.f;
            }
            continue; }
        const int half = (ph - 1) / 13, sp = (ph - 1) % 13;
        if (DIAG_K >= 0 && sp > DIAG_K) continue;
        switch (sp) {
        case 0: norm_phase<0>(p, half); break;
        case 1: g_in(p, half, lds); if (REPEAT_SP == 1) { __syncthreads(); g_in(p, half, lds); } break;
        case 2: s1_phase(p, half, (float*)shm); break;
        case 3: g_pool(p, half, lds); mix1_quads(p, half, lds); break;
        case 4: g_a(p, half, lds); passb(p); break;
        case 5: passc(p, half, lds); break;
        case 6: s5_phase(p); break;
        case 7: g_b(p, half, lds); break;
        case 8: g_out(p, half, lds); break;
        case 9: norm_phase<1>(p, half); break;
        case 10: g_f1(p, half, lds); break;
        case 11: g_f2(p, half, lds); break;
        default: norm_phase<2>(p, half); break;
        }
    }
}

extern "C" void kernel_launch(void* const* d_in, const int* in_sizes, int n_in, void* d_out, int out_size, void* d_ws, size_t ws_size, hipStream_t stream) {
    static int grid = 0;
    if (grid == 0) {
        int dev = 0, cus = 0, per_cu = 0;
        (void)hipGetDevice(&dev);
        (void)hipDeviceGetAttribute(&cus, hipDeviceAttributeMultiprocessorCount, dev);
        if (hipFuncSetAttribute((const void*)mega, hipFuncAttributeMaxDynamicSharedMemorySize, LDS_BYTES) != hipSuccess) { fprintf(stderr, "hipFuncSetAttribute failed\n"); grid = -1; return; }
        if (hipOccupancyMaxActiveBlocksPerMultiprocessor(&per_cu, (const void*)mega, 512, LDS_BYTES) != hipSuccess || per_cu < 1) { fprintf(stderr, "occupancy query failed (%d)\n", per_cu); (void)hipGetLastError(); per_cu = 1; }
        grid = cus * 1;
        if (ws_size < WS_END) { fprintf(stderr, "workspace too small: %zu < %zu\n", ws_size, (size_t)WS_END); grid = -1; return; }
    }
    if (grid < 0) return;
    Params p{};
    for (int i = 0; i < 27; ++i) p.in[i] = (const float*)d_in[i];
    p.out = (float*)d_out; p.ws = (unsigned char*)d_ws;
#if MULTI_LAUNCH
    for (int ph = 0; ph < NPHASE; ++ph) { p.ph_lo = ph; p.ph_hi = ph + 1; hipLaunchKernelGGL(mega, dim3(grid), dim3(512), LDS_BYTES, stream, p); }
#else
    p.ph_lo = 0; p.ph_hi = NPHASE;
    void* args[] = {&p};
    hipError_t e = hipLaunchCooperativeKernel((const void*)mega, dim3(grid), dim3(512), args, LDS_BYTES, stream);
    if (e != hipSuccess) fprintf(stderr, "cooperative launch failed: %s (grid %d)\n", hipGetErrorString(e), grid);
#endif
}
```

```cpp
#include <hip/hip_runtime.h>
#include <hip/hip_cooperative_groups.h>
#include <cstdio>
namespace cg = cooperative_groups;

#ifndef MULTI_LAUNCH
#define MULTI_LAUNCH 0
#endif

#define LAS __attribute__((address_space(3)))
typedef unsigned short bf16_t;
typedef short bf16x8 __attribute__((ext_vector_type(8)));
typedef short bf16x4 __attribute__((ext_vector_type(4)));
typedef float f32x4 __attribute__((ext_vector_type(4)));
typedef float f32x2 __attribute__((ext_vector_type(2)));
typedef unsigned u32x4 __attribute__((ext_vector_type(4)));
typedef unsigned u32x2 __attribute__((ext_vector_type(2)));

constexpr int DM = 1024, HR = 9216  , NCHK = 144  ;
constexpr int NH = 32, DFF = 2816, NIN = 8224, NINP = 8448;
constexpr int LDS_BYTES = 131072 + 16;
#ifndef REPEAT_SP
#define REPEAT_SP -1
#endif
#ifndef DIAG_K
#define DIAG_K -1
#endif
#ifndef SANITIZE
#define SANITIZE 0
#endif
constexpr int NPHASE = 27 + SANITIZE;

constexpr size_t WS_WIN = 0;
constexpr size_t WS_WGRP = WS_WIN + (size_t)NINP * 1024 * 2;
constexpr size_t WS_WA = WS_WGRP + (size_t)1024 * 256 * 2;
constexpr size_t WS_WB = WS_WA + (size_t)1024 * 1024 * 2;
constexpr size_t WS_WOUT = WS_WB + (size_t)1024 * 2048 * 2;
constexpr size_t WS_WF1 = WS_WOUT + (size_t)1024 * 1024 * 2;
constexpr size_t WS_WF2 = WS_WF1 + (size_t)5632 * 1024 * 2;
constexpr size_t WS_MOD = WS_WF2 + (size_t)1024 * 2816 * 2;
constexpr size_t WS_H = WS_MOD + (size_t)34 * 6144 * 4;
constexpr size_t WS_Z = WS_H + (size_t)HR * 1024 * 2;
constexpr size_t WS_X = WS_Z + (size_t)HR * 2048 * 2;
constexpr size_t WS_AM = WS_X + (size_t)HR * 2048 * 2;
constexpr size_t WS_GB = WS_X + (size_t)HR * 3072 * 2;
constexpr size_t WS_XT = WS_GB + (size_t)HR * 1024 * 2;
constexpr size_t WS_BT = WS_XT + (size_t)HR * 2048 * 2;
constexpr size_t WS_CM = WS_BT + (size_t)NCHK * 4 * 128 * 64 * 2;
constexpr size_t WS_BM = WS_CM + (size_t)NCHK * 4 * 128 * 64 * 2;
constexpr size_t WS_CB = WS_BM + (size_t)NCHK * 4 * 128 * 64 * 2;
constexpr size_t WS_ST = WS_CB + (size_t)NCHK * 4 * 64 * 64 * 2;
constexpr size_t WS_DTR = WS_ST + (size_t)15 * 32 * 64 * 128 * 4;
constexpr size_t WS_DTC = WS_DTR + (size_t)HR * 32 * 4;
constexpr size_t WS_ACS = WS_DTC + (size_t)HR * 32 * 4;
constexpr size_t WS_BAR = WS_ACS + (size_t)HR * 32 * 4;
constexpr size_t WS_END = WS_BAR + 16384;
static_assert(WS_END <= (size_t)256 * 1024 * 1024, "workspace");

constexpr size_t O_Y = 0;
constexpr size_t O_POOLP = 18874368;
constexpr size_t O_CONVP = O_POOLP + 30720;
constexpr size_t O_SSMP = O_CONVP + 18432;
constexpr size_t O_POOLS = O_SSMP + 524288;
constexpr size_t O_CONVS = O_POOLS + 491520;
constexpr size_t O_SSMS = O_CONVS + 294912;

struct Params {
    const float* in[27];
    float* out;
    unsigned char* ws;
    int ph_lo, ph_hi;
};

typedef __bf16 bfx2_t __attribute__((ext_vector_type(2)));
__device__ __forceinline__ unsigned cvt_pk_bf16(float lo, float hi) { const f32x2 v = {lo, hi}; return __builtin_bit_cast(unsigned, __builtin_convertvector(v, bfx2_t)); }
__device__ __forceinline__ float bf2f(short b) { return __uint_as_float(((unsigned)(unsigned short)b) << 16); }
__device__ __forceinline__ float bflo(unsigned w) { return __uint_as_float(w << 16); }
__device__ __forceinline__ float bfhi(unsigned w) { return __uint_as_float(w & 0xffff0000u); }
__device__ __forceinline__ float sigmoidf_(float x) { return 1.0f / (1.0f + __expf(-x)); }
__device__ __forceinline__ float siluf_(float x) { return x / (1.0f + __expf(-x)); }
__device__ __forceinline__ int segoff(int half, int pm) { return pm < 32 ? half * 8192 : 8192 + half * 1024; }
__device__ __forceinline__ int gtok(int half, int r) { return r + (r < 8192 ? half * 8192 : 8192 + half * 1024); }
__device__ __forceinline__ int modrow(int half, int r) { return r < 8192 ? half : 2 + 16 * half + ((r - 8192) >> 6); }
__device__ __forceinline__ int otid() { int t = threadIdx.x; asm volatile("" : "+v"(t)); return t; }
__device__ __forceinline__ int obid() { int b = blockIdx.x; asm volatile("" : "+s"(b)); return b; }
__device__ __forceinline__ float wave_sum(float v) {
#pragma unroll
    for (int o = 32; o > 0; o >>= 1) v += __shfl_xor(v, o, 64);
    return v;
}

#define XB_TMO      128
#define XB_XCNT(j)  (256  + 64 * (j))
#define XB_XSUB(j)  (1280 + 64 * (j))
#define XB_XGEN(j)  (2304 + 64 * (j))
#define XB_TOP      3328
#define XB_TOPGEN   3392
#define XCD_BAR_WORDS 3456
#define XB_SPIN_CAP (1u << 18)

__device__ __forceinline__ unsigned xb_ld(unsigned* p)              { return __hip_atomic_load(p, __ATOMIC_RELAXED, __HIP_MEMORY_SCOPE_AGENT); }
__device__ __forceinline__ unsigned xb_add(unsigned* p, unsigned v) { return __hip_atomic_fetch_add(p, v, __ATOMIC_RELAXED, __HIP_MEMORY_SCOPE_AGENT); }
__device__ __forceinline__ unsigned xb_xcc_id() { return (unsigned)__builtin_amdgcn_s_getreg((3 << 11) | 20) & 0xFu; }
#define XB_SPIN(cond, bar) do { unsigned _sp = 0; while (cond) { __builtin_amdgcn_s_sleep(1); \
    if ((++_sp & 255u) == 0u) { if (xb_ld(&(bar)[XB_TMO])) break; if (_sp > XB_SPIN_CAP) { atomicAdd(&(bar)[XB_TMO], 1u); break; } } } } while (0)

struct XcdBarrier {
    unsigned* bar; unsigned x;
    volatile LAS unsigned* st;
};

__device__ __forceinline__ XcdBarrier xcd_barrier_post(unsigned* bar, volatile LAS unsigned* st) {
    XcdBarrier b; b.bar = bar; b.x = xb_xcc_id(); b.st = st;
    if (threadIdx.x == 0) (void)xb_add(&bar[XB_XCNT(b.x)], 1u);
    return b;
}
__device__ __forceinline__ void xcd_barrier_complete(unsigned* bar, unsigned x, unsigned& nloc, unsigned& nx) {
    const unsigned G = gridDim.x * gridDim.y * gridDim.z;
    unsigned sum, cnt, mine, sp = 0u;
    for (;;) {
        sum = 0u; cnt = 0u; mine = 0u;
#pragma unroll
        for (unsigned j = 0; j < 16; ++j) { const unsigned c = xb_ld(&bar[XB_XCNT(j)]); sum += c; cnt += (c > 0u) ? 1u : 0u; mine = (j == x) ? c : mine; }
        if (sum == G) break;
        __builtin_amdgcn_s_sleep(1);
        if ((++sp & 255u) == 0u) { if (xb_ld(&bar[XB_TMO])) break; if (sp > XB_SPIN_CAP) { atomicAdd(&bar[XB_TMO], 1u); break; } }
    }
    nloc = mine > 0u ? mine : 1u; nx = cnt > 0u ? cnt : 1u;
}

__device__ __forceinline__ void xcd_barrier(const XcdBarrier& b) {
    asm volatile("s_waitcnt vmcnt(0)" ::: "memory");
    __syncthreads();
    if (threadIdx.x == 0) {
        unsigned* bar = b.bar;
        __builtin_amdgcn_s_waitcnt(0);
        unsigned nloc = b.st[0], nx = b.st[1];
        if (nloc == 0u) { xcd_barrier_complete(bar, b.x, nloc, nx); b.st[0] = nloc; b.st[1] = nx; }
        const unsigned old = xb_add(&bar[XB_XSUB(b.x)], 1u);
        const unsigned gen = old / nloc;
        if (old + 1u == (gen + 1u) * nloc) {
            __builtin_amdgcn_fence(__ATOMIC_RELEASE, "agent");
            asm volatile("s_waitcnt vmcnt(0)" ::: "memory");
            const unsigned og = xb_add(&bar[XB_TOP], 1u);
            const unsigned tg = og / nx;
            if (og + 1u == (tg + 1u) * nx) xb_add(&bar[XB_TOPGEN], 1u);
            else XB_SPIN(xb_ld(&bar[XB_TOPGEN]) == tg, bar);
            __builtin_amdgcn_fence(__ATOMIC_ACQUIRE, "agent");
            xb_add(&bar[XB_XGEN(b.x)], 1u);
            asm volatile("s_waitcnt vmcnt(0)" ::: "memory");
        } else {
            XB_SPIN(xb_ld(&bar[XB_XGEN(b.x)]) == gen, bar);
            __builtin_amdgcn_fence(__ATOMIC_ACQUIRE, "agent");
            asm volatile("s_waitcnt vmcnt(0)" ::: "memory");
        }
    }
    __syncthreads();
}


namespace pg8 {
constexpr int BM = 256, BK = 64, HALF = 128, HTB = HALF * BK * 2, STAGE_BYTES = 8 * HTB, NXCD = 8, WGM = 8;
__device__ __forceinline__ int lds_byte(int r, int c) { const int st = (r >> 4) * 2 + (c >> 5), rr = r & 15, cc = c & 31, ob = rr * 64 + cc * 2; return st * 1024 + (ob ^ (((ob >> 9) & 1) << 5)); }
__device__ __forceinline__ void stage_rc(int b, int& R, int& C) { const int st = b / 1024, sb = b % 1024, swz = sb ^ (((sb >> 9) & 1) << 5); R = (st >> 1) * 16 + swz / 64; C = (st & 1) * 32 + (swz % 64) / 2; }
__device__ __forceinline__ int perm32(int rho) { const int n = rho >> 4, i = rho & 15; return 8 * (i >> 2) + 4 * n + (i & 3); }
struct Unit { int pm, pn; };
struct Gemm { const bf16_t* A; const bf16_t* Bt; int M, N, K, lda, ldb, acoff; };
struct StaticOrder {
    int nM, nN, nwg, G, c;
    __device__ void init(int M, int N, int G_, int c_) { nM = M / BM; nN = N / BM; nwg = nM * nN; G = G_; c = c_; }
    __device__ bool next(int i, Unit& u) const {
        const long L = (long)i * G + c; if (L >= nwg) return false;
        int wgid = (int)L; { const int q = nwg / NXCD, r = nwg % NXCD, xcd = wgid % NXCD, off = wgid / NXCD; wgid = (xcd < r ? xcd * (q + 1) : r * (q + 1) + (xcd - r) * q) + off; }
        const int nig = WGM * nN, gid = wgid / nig, fm = gid * WGM, gsz = (nM - fm) < WGM ? (nM - fm) : WGM;
        u.pm = fm + ((wgid % nig) % gsz); u.pn = (wgid % nig) / gsz; return true;
    }
};

template <class Epi>
__device__ __forceinline__ void gemm_phase(LAS unsigned char* lds, const Gemm g, const StaticOrder& S, const Epi& E) {
    const int tid = otid(), wid = __builtin_amdgcn_readfirstlane(tid >> 6), lane = tid & 63, wr = wid >> 2, wc = wid & 3, fr = lane & 15, fq = lane >> 4;
    const int nt = g.K / BK;
    unsigned voffA[2], voffB[2];
#pragma unroll
    for (int i = 0; i < 2; ++i) { int R, C; stage_rc(tid * 16 + i * 8192, R, C); const int Rb = Epi::PERM ? ((R & ~31) + perm32(R & 31)) : R;
        voffA[i] = (unsigned)(R * g.lda + C) * 2u; voffB[i] = (unsigned)(Rb * g.ldb + C) * 2u; }
    const size_t kstep = (size_t)(BK * 2);
    const size_t hstepA = (size_t)HALF * g.lda * 2, hstepB = (size_t)HALF * g.ldb * 2;
    const size_t tstepA = 2 * hstepA, tstepB = 2 * hstepB;
    const unsigned ldsw = (unsigned)wid * 1024u;
    const int aoff = lds_byte(wr * 64 + fr, fq * 8), boff = lds_byte(wc * 32 + fr, fq * 8);
#define PG8_SA(b, h) (((b) * 2 + (h)) * HTB)
#define PG8_SB(b, h) ((4 + (b) * 2 + (h)) * HTB)
#define PG8_STAGE(bufoff, gbase, voff) do { _Pragma("unroll") for (int _i = 0; _i < 2; ++_i) \
        __builtin_amdgcn_global_load_lds((const unsigned*)((const char*)(gbase) + (voff)[_i]), (LAS unsigned*)(lds + (bufoff) + ldsw + _i * 8192), 16, 0, 0); } while (0)
#define PG8_LDA(dst, b, h) do { _Pragma("unroll") for (int m = 0; m < 4; ++m) _Pragma("unroll") for (int k = 0; k < 2; ++k) dst[m][k] = *(const LAS bf16x8*)(lds + PG8_SA(b, h) + aoff + m * 2048 + k * 1024); } while (0)
#define PG8_LDB(dst, b, h) do { _Pragma("unroll") for (int n = 0; n < 2; ++n) _Pragma("unroll") for (int k = 0; k < 2; ++k) dst[n][k] = *(const LAS bf16x8*)(lds + PG8_SB(b, h) + boff + n * 2048 + k * 1024); } while (0)
#define PG8_MMA(ai, bj, At, Bt) do { __builtin_amdgcn_s_setprio(1); _Pragma("unroll") for (int m = 0; m < 4; ++m) _Pragma("unroll") for (int n = 0; n < 2; ++n) _Pragma("unroll") for (int k = 0; k < 2; ++k) \
        acc[ai][bj][m][n] = __builtin_amdgcn_mfma_f32_16x16x32_bf16(Bt[n][k], At[m][k], acc[ai][bj][m][n], 0, 0, 0); __builtin_amdgcn_s_setprio(0); } while (0)
#define PG8_WAIT_V(n) asm volatile("s_waitcnt vmcnt(" #n ")" ::: "memory")
#define PG8_WAIT_L(n) asm volatile("s_waitcnt lgkmcnt(" #n ")" ::: "memory")
#define PG8_BAR __builtin_amdgcn_s_barrier()
#define PG8_SCHED __builtin_amdgcn_sched_barrier(0)
    Unit cur, nxt; int ui = 0;
    if (!S.next(0, cur)) return;
    f32x4 acc[2][2][4][2];
#pragma unroll
    for (int a = 0; a < 2; ++a)
#pragma unroll
        for (int b = 0; b < 2; ++b)
#pragma unroll
            for (int m = 0; m < 4; ++m)
#pragma unroll
                for (int n = 0; n < 2; ++n) acc[a][b][m][n] = (f32x4){0.f, 0.f, 0.f, 0.f};
    bf16x8 At[4][2], B0[2][2], B1[2][2];
    const char* cA = (const char*)g.A + (size_t)cur.pm * tstepA + (size_t)cur.pn * g.acoff * 2; const char* cB = (const char*)g.Bt + (size_t)cur.pn * tstepB;
    PG8_STAGE(PG8_SB(0, 0), cB, voffB); PG8_STAGE(PG8_SA(0, 0), cA, voffA); PG8_STAGE(PG8_SB(0, 1), cB + hstepB, voffB); PG8_STAGE(PG8_SA(0, 1), cA + hstepA, voffA);
    if (wr == 1) PG8_BAR;
    PG8_WAIT_V(4); PG8_BAR;
    PG8_STAGE(PG8_SB(1, 0), cB + kstep, voffB); PG8_STAGE(PG8_SA(1, 0), cA + kstep, voffA); PG8_STAGE(PG8_SB(1, 1), cB + hstepB + kstep, voffB);
    PG8_WAIT_V(6); PG8_BAR;
    for (;;) {
        const bool has_next = S.next(ui + 1, nxt);
        const char* nA = has_next ? (const char*)g.A + (size_t)nxt.pm * tstepA + (size_t)nxt.pn * g.acoff * 2 : cA; const char* nB = has_next ? (const char*)g.Bt + (size_t)nxt.pn * tstepB : cB;
#pragma unroll 1
        for (int t = 0; t < nt; t += 2) {
            const bool last = (t == nt - 2);
            const char* a1 = cA + (size_t)(t + 1) * kstep;
            const char* a2 = last ? nA : cA + (size_t)(t + 2) * kstep; const char* b2 = last ? nB : cB + (size_t)(t + 2) * kstep;
            const char* a3 = a2 + kstep; const char* b3 = b2 + kstep;
            PG8_LDB(B0, 0, 0); PG8_SCHED; PG8_LDA(At, 0, 0); PG8_STAGE(PG8_SA(1, 1), a1 + hstepA, voffA);
            PG8_WAIT_L(8); PG8_BAR; PG8_WAIT_L(0); PG8_MMA(0, 0, At, B0); PG8_BAR; PG8_SCHED;
            PG8_LDB(B1, 0, 1); PG8_STAGE(PG8_SB(0, 0), b2, voffB);
            PG8_BAR; PG8_WAIT_L(0); PG8_MMA(0, 1, At, B1); PG8_BAR;
            PG8_LDA(At, 0, 1); PG8_STAGE(PG8_SA(0, 0), a2, voffA);
            PG8_BAR; PG8_WAIT_L(0); PG8_MMA(1, 0, At, B0); PG8_BAR; PG8_SCHED;
            PG8_STAGE(PG8_SB(0, 1), b2 + hstepB, voffB);
            PG8_WAIT_V(6); PG8_BAR; PG8_MMA(1, 1, At, B1); PG8_BAR;
            PG8_LDB(B0, 1, 0); PG8_SCHED; PG8_LDA(At, 1, 0); PG8_STAGE(PG8_SA(0, 1), a2 + hstepA, voffA);
            PG8_WAIT_L(8); PG8_BAR; PG8_WAIT_L(0); PG8_MMA(0, 0, At, B0); PG8_BAR; PG8_SCHED;
            PG8_LDB(B1, 1, 1); PG8_STAGE(PG8_SB(1, 0), b3, voffB);
            PG8_BAR; PG8_WAIT_L(0); PG8_MMA(0, 1, At, B1); PG8_BAR;
            PG8_LDA(At, 1, 1); PG8_STAGE(PG8_SA(1, 0), a3, voffA);
            PG8_BAR; PG8_WAIT_L(0); PG8_MMA(1, 0, At, B0); PG8_BAR; PG8_SCHED;
            PG8_STAGE(PG8_SB(1, 1), b3 + hstepB, voffB);
            PG8_WAIT_V(6); PG8_BAR; PG8_MMA(1, 1, At, B1); PG8_BAR;
        }
        E(acc, cur, wr, wc, fr, fq);
        if (!has_next) break;
#pragma unroll
        for (int a = 0; a < 2; ++a)
#pragma unroll
            for (int b = 0; b < 2; ++b)
#pragma unroll
                for (int m = 0; m < 4; ++m)
#pragma unroll
                    for (int n = 0; n < 2; ++n) acc[a][b][m][n] = (f32x4){0.f, 0.f, 0.f, 0.f};
        cur = nxt; cA = nA; cB = nB; ++ui;
    }
    PG8_WAIT_V(0);
    if (wr == 0) PG8_BAR;
    PG8_BAR;
#undef PG8_SA
#undef PG8_SB
#undef PG8_STAGE
#undef PG8_LDA
#undef PG8_LDB
#undef PG8_MMA
#undef PG8_WAIT_V
#undef PG8_WAIT_L
#undef PG8_BAR
#undef PG8_SCHED
}
}
using pg8::Unit;
typedef f32x4 AccT[2][2][4][2];

struct EpiIn {
    static constexpr bool PERM = true;
    unsigned char* ws; float* out; int half;
    __device__ __forceinline__ void operator()(const AccT& acc, const Unit& u, int wr, int wc, int fr, int fq) const {
        const int pn = u.pn; const int row0 = u.pm * 256 + wr * 64 + fr;
        if (pn == 32) {
            if (wc == 0) { float* D = (float*)(ws + WS_DTR);
#pragma unroll
                for (int ai = 0; ai < 2; ++ai)
#pragma unroll
                    for (int m = 0; m < 4; ++m) { const int r = row0 + ai * 128 + m * 16;
                        *(f32x4*)(D + (size_t)r * 32 + 8 * fq) = acc[ai][0][m][0]; *(f32x4*)(D + (size_t)r * 32 + 8 * fq + 4) = acc[ai][0][m][1]; } }
            return; }
        bf16_t* base; int ld, radd = 0, c0; bool sig = false;
        if (pn < 4) { base = (bf16_t*)out; ld = 2048; radd = segoff(half, u.pm); c0 = pn * 256; }
        else if (pn < 12) { base = (bf16_t*)(ws + WS_Z); ld = 2048; c0 = (pn - 4) * 256; }
        else if (pn < 24) { base = (bf16_t*)(ws + WS_X); ld = 3072; c0 = (pn - 12) * 256; }
        else if (pn < 28) { base = (bf16_t*)out + 1024; ld = 2048; radd = segoff(half, u.pm); c0 = (pn - 24) * 256; sig = true; }
        else { base = (bf16_t*)(ws + WS_GB); ld = 1024; c0 = (pn - 28) * 256; sig = true; }
        const int col0 = c0 + wc * 32 + 8 * fq;
#pragma unroll
        for (int ai = 0; ai < 2; ++ai)
#pragma unroll
            for (int m = 0; m < 4; ++m) { bf16_t* rowp = base + (size_t)(row0 + radd + ai * 128 + m * 16) * ld + col0;
#pragma unroll
                for (int bj = 0; bj < 2; ++bj) { f32x4 v0 = acc[ai][bj][m][0], v1 = acc[ai][bj][m][1];
                    if (sig) {
#pragma unroll
                        for (int j = 0; j < 4; ++j) { v0[j] = sigmoidf_(v0[j]); v1[j] = sigmoidf_(v1[j]); } }
                    u32x4 w; w.x = cvt_pk_bf16(v0[0], v0[1]); w.y = cvt_pk_bf16(v0[2], v0[3]); w.z = cvt_pk_bf16(v1[0], v1[1]); w.w = cvt_pk_bf16(v1[2], v1[3]);
                    *(u32x4*)(rowp + bj * 128) = w; } }
    }
};
struct EpiPool {
    static constexpr bool PERM = true;
    bf16_t* O; const float* scale;
    __device__ __forceinline__ void operator()(const AccT& acc, const Unit& u, int wr, int wc, int fr, int fq) const {
        const int row0 = u.pm * 256 + wr * 64 + fr, col0 = u.pn * 256 + wc * 32 + 8 * fq;
        f32x4 sv[2][2];
#pragma unroll
        for (int bj = 0; bj < 2; ++bj)
#pragma unroll
            for (int n = 0; n < 2; ++n) sv[bj][n] = *(const f32x4*)(scale + col0 + bj * 128 + 4 * n);
#pragma unroll
        for (int ai = 0; ai < 2; ++ai)
#pragma unroll
            for (int m = 0; m < 4; ++m) { bf16_t* rowp = O + (size_t)(row0 + ai * 128 + m * 16) * 1024 + col0;
#pragma unroll
                for (int bj = 0; bj < 2; ++bj) { f32x4 v0 = acc[ai][bj][m][0] * sv[bj][0], v1 = acc[ai][bj][m][1] * sv[bj][1];
                    u32x4 w; w.x = cvt_pk_bf16(v0[0], v0[1]); w.y = cvt_pk_bf16(v0[2], v0[3]); w.z = cvt_pk_bf16(v1[0], v1[1]); w.w = cvt_pk_bf16(v1[2], v1[3]);
                    *(u32x4*)(rowp + bj * 128) = w; } }
    }
};
struct EpiA {
    static constexpr bool PERM = true;
    bf16_t* O; const bf16_t* GA  ; int half;
    __device__ __forceinline__ void operator()(const AccT& acc, const Unit& u, int wr, int wc, int fr, int fq) const {
        const int row0 = u.pm * 256 + wr * 64 + fr, col0 = u.pn * 256 + wc * 32 + 8 * fq, radd = segoff(half, u.pm);
#pragma unroll
        for (int ai = 0; ai < 2; ++ai)
#pragma unroll
            for (int m = 0; m < 4; ++m) { const int r = row0 + ai * 128 + m * 16; bf16_t* rowp = O + (size_t)r * 1024 + col0; const bf16_t* gp = GA + (size_t)(r + radd) * 2048 + col0;
#pragma unroll
                for (int bj = 0; bj < 2; ++bj) { const u32x4 gv = *(const u32x4*)(gp + bj * 128); const f32x4 v0 = acc[ai][bj][m][0], v1 = acc[ai][bj][m][1];
                    u32x4 w; w.x = cvt_pk_bf16(v0[0] * bflo(gv.x), v0[1] * bfhi(gv.x)); w.y = cvt_pk_bf16(v0[2] * bflo(gv.y), v0[3] * bfhi(gv.y));
                    w.z = cvt_pk_bf16(v1[0] * bflo(gv.z), v1[1] * bfhi(gv.z)); w.w = cvt_pk_bf16(v1[2] * bflo(gv.w), v1[3] * bfhi(gv.w));
                    *(u32x4*)(rowp + bj * 128) = w; } }
    }
};
struct EpiB {
    static constexpr bool PERM = true;
    bf16_t* GBM; const bf16_t* MA;
    __device__ __forceinline__ void operator()(const AccT& acc, const Unit& u, int wr, int wc, int fr, int fq) const {
        const int row0 = u.pm * 256 + wr * 64 + fr, col0 = u.pn * 256 + wc * 32 + 8 * fq;
#pragma unroll
        for (int ai = 0; ai < 2; ++ai)
#pragma unroll
            for (int m = 0; m < 4; ++m) { const size_t ro = (size_t)(row0 + ai * 128 + m * 16) * 1024 + col0;
#pragma unroll
                for (int bj = 0; bj < 2; ++bj) { const u32x4 gv = *(const u32x4*)(GBM + ro + bj * 128); const u32x4 av = *(const u32x4*)(MA + ro + bj * 128); const f32x4 v0 = acc[ai][bj][m][0], v1 = acc[ai][bj][m][1];
                    u32x4 w; w.x = cvt_pk_bf16(bflo(av.x) + v0[0] * bflo(gv.x), bfhi(av.x) + v0[1] * bfhi(gv.x)); w.y = cvt_pk_bf16(bflo(av.y) + v0[2] * bflo(gv.y), bfhi(av.y) + v0[3] * bfhi(gv.y));
                    w.z = cvt_pk_bf16(bflo(av.z) + v1[0] * bflo(gv.z), bfhi(av.z) + v1[1] * bfhi(gv.z)); w.w = cvt_pk_bf16(bflo(av.w) + v1[2] * bflo(gv.w), bfhi(av.w) + v1[3] * bfhi(gv.w));
                    *(u32x4*)(GBM + ro + bj * 128) = w; } }
    }
};
struct EpiRes {
    static constexpr bool PERM = false;
    float* dst; const float* xp; const float* xs; const float* mod; int goff; int half; int inplace;
    __device__ __forceinline__ void operator()(const AccT& acc, const Unit& u, int wr, int wc, int fr, int fq) const {
        const int row0 = u.pm * 256 + wr * 64 + fr, col0 = u.pn * 256 + wc * 32 + 4 * fq;
#pragma unroll
        for (int ai = 0; ai < 2; ++ai)
#pragma unroll
            for (int m = 0; m < 4; ++m) { const int r = row0 + ai * 128 + m * 16; const int gt = gtok(half, r);
                float* dp = dst + (size_t)gt * 1024 + col0;
                const float* sp = inplace ? dp : (r < 8192 ? xp + (size_t)(half * 8192 + r) * 1024 + col0 : xs + (size_t)(half * 1024 + r - 8192) * 1024 + col0);
                const float* gp = mod + (size_t)modrow(half, r) * 6144 + goff + col0;
#pragma unroll
                for (int bj = 0; bj < 2; ++bj)
#pragma unroll
                    for (int n = 0; n < 2; ++n) { const int o = bj * 128 + n * 16; const f32x4 s = *(const f32x4*)(sp + o), gg = *(const f32x4*)(gp + o);
                        *(f32x4*)(dp + o) = s + gg * acc[ai][bj][m][n]; } }
    }
};
struct EpiF1 {
    static constexpr bool PERM = false;
    bf16_t* O;
    __device__ __forceinline__ void operator()(const AccT& acc, const Unit& u, int wr, int wc, int fr, int fq) const {
        const int row0 = u.pm * 256 + wr * 64 + fr, col0 = u.pn * 128 + wc * 16 + 4 * fq;
#pragma unroll
        for (int ai = 0; ai < 2; ++ai)
#pragma unroll
            for (int m = 0; m < 4; ++m) { bf16_t* rowp = O + (size_t)(row0 + ai * 128 + m * 16) * DFF + col0;
#pragma unroll
                for (int bj = 0; bj < 2; ++bj) { const f32x4 a = acc[ai][bj][m][0], b = acc[ai][bj][m][1];
                    u32x2 w; w.x = cvt_pk_bf16(siluf_(a[0]) * b[0], siluf_(a[1]) * b[1]); w.y = cvt_pk_bf16(siluf_(a[2]) * b[2], siluf_(a[3]) * b[3]);
                    *(u32x2*)(rowp + bj * 64) = w; } }
    }
};

__device__ __forceinline__ const float* wsrc(const Params& p, int w, int r, int& ld) {
    switch (w) {
    case 0: { ld = NIN; const float* b = p.in[11]; if (r < 6144) return b + r; if (r < 8192) return b + r + 32; if (r < 8224) return b + 6144 + (r - 8192); return nullptr; }
    case 1: ld = 256; return p.in[12] + (size_t)(r >> 8) * 65536 + (r & 255);
    case 2: ld = 1024; return p.in[20] + r;
    case 3: ld = 1024; return p.in[21] + r;
    case 4: ld = 1024; return p.in[22] + r;
    case 5: { ld = DFF; const int pn = r >> 8, bj = (r >> 7) & 1, wc = (r >> 5) & 3, n = (r >> 4) & 1, fq = (r >> 2) & 3, e = r & 3; const int G = pn * 128 + bj * 64 + wc * 16 + fq * 4 + e; return (n ? p.in[24] : p.in[23]) + G; }
    default: ld = 1024; return p.in[25] + r;
    }
}
__device__ __forceinline__ void phase0(const Params& p, float* lds) {
    const int t = otid(), bid = obid();
    const int total_tiles = 2112 + 64 + 256 + 512 + 256 + 1408 + 704;
    for (int item = bid; item < 96 + total_tiles; item += gridDim.x) {
        if (item < 96) {
            const int slab = item, jc = t & 63, kg = t >> 6;
            float acc[34];
#pragma unroll
            for (int b = 0; b < 34; ++b) acc[b] = 0.f;
            for (int kh = 0; kh < 2; ++kh) {
                __syncthreads();
                for (int o = t; o < 34 * 512; o += 512) { const int b = o >> 9, kk = o & 511; const float cv = (b < 2 ? p.in[2] + b * 1024 : p.in[3] + (b - 2) * 1024)[kh * 512 + kk]; lds[o] = siluf_(cv); }
                __syncthreads();
                for (int kk = kg * 64; kk < kg * 64 + 64; ++kk) { const float wv = p.in[7][(size_t)(kh * 512 + kk) * 6144 + slab * 64 + jc];
#pragma unroll
                    for (int b = 0; b < 34; ++b) acc[b] += lds[b * 512 + kk] * wv; }
            }
            __syncthreads();
#pragma unroll
            for (int b = 0; b < 34; ++b) lds[(kg * 34 + b) * 64 + jc] = acc[b];
            __syncthreads();
            for (int o = t; o < 34 * 64; o += 512) { const int b = o >> 6, j = o & 63; float s = 0.f;
#pragma unroll
                for (int k8 = 0; k8 < 8; ++k8) s += lds[(k8 * 34 + b) * 64 + j];
                ((float*)(p.ws + WS_MOD))[b * 6144 + slab * 64 + j] = s + p.in[8][slab * 64 + j]; }
            __syncthreads();
        } else {
            int ti = item - 96, w, ktw; size_t wow;
            if (ti < 2112) { w = 0; ktw = 16; wow = WS_WIN; }
            else if ((ti -= 2112) < 64) { w = 1; ktw = 4; wow = WS_WGRP; }
            else if ((ti -= 64) < 256) { w = 2; ktw = 16; wow = WS_WA; }
            else if ((ti -= 256) < 512) { w = 3; ktw = 32; wow = WS_WB; }
            else if ((ti -= 512) < 256) { w = 4; ktw = 16; wow = WS_WOUT; }
            else if ((ti -= 256) < 1408) { w = 5; ktw = 16; wow = WS_WF1; }
            else { ti -= 1408; w = 6; ktw = 44; wow = WS_WF2; }
            const int K = ktw * 64, r0 = (ti / ktw) * 64, k0 = (ti % ktw) * 64;
            { const int rr = t & 63, kq = t >> 6; int ld; const float* sp = wsrc(p, w, r0 + rr, ld);
#pragma unroll
                for (int i = 0; i < 8; ++i) { const int kl = kq + 8 * i; lds[kl * 65 + rr] = sp ? sp[(size_t)(k0 + kl) * ld] : 0.f; } }
            __syncthreads();
            { const int ro = t >> 3, kk = (t & 7) * 8; float v[8];
#pragma unroll
                for (int j = 0; j < 8; ++j) v[j] = lds[(kk + j) * 65 + ro];
                u32x4 o; o.x = cvt_pk_bf16(v[0], v[1]); o.y = cvt_pk_bf16(v[2], v[3]); o.z = cvt_pk_bf16(v[4], v[5]); o.w = cvt_pk_bf16(v[6], v[7]);
                *(u32x4*)((bf16_t*)(p.ws + wow) + (size_t)(r0 + ro) * K + k0 + kk) = o; }
            __syncthreads();
        }
    }
}

template <int MODE>
__device__ __forceinline__ void norm_phase(const Params& p, int half) {
    const int t_ = otid(), bid = obid(); const int lane = t_ & 63, wv = t_ >> 6;
    const float* w = MODE == 0 ? p.in[9] : (MODE == 1 ? p.in[10] : p.in[26]);
    f32x4 wq[4];
#pragma unroll
    for (int i = 0; i < 4; ++i) wq[i] = *(const f32x4*)(w + i * 256 + lane * 4);
    for (int r = bid * 8 + wv; r < HR; r += gridDim.x * 8) {
        const float* src;
        if (MODE == 0) src = r < 8192 ? p.in[0] + (size_t)(half * 8192 + r) * 1024 : p.in[1] + (size_t)(half * 1024 + r - 8192) * 1024;
        else src = p.out + (size_t)gtok(half, r) * 1024;
        f32x4 v[4]; float ss = 0.f;
#pragma unroll
        for (int i = 0; i < 4; ++i) { v[i] = *(const f32x4*)(src + i * 256 + lane * 4); ss += v[i][0] * v[i][0] + v[i][1] * v[i][1] + v[i][2] * v[i][2] + v[i][3] * v[i][3]; }
        ss = wave_sum(ss);
        const float rstd = rsqrtf(ss * (1.0f / 1024.0f) + 1e-6f);
        if (MODE == 2) {
            float* dst = p.out + (size_t)gtok(half, r) * 1024;
#pragma unroll
            for (int i = 0; i < 4; ++i) *(f32x4*)(dst + i * 256 + lane * 4) = v[i] * rstd * wq[i];
        } else {
            const float* mr = (const float*)(p.ws + WS_MOD) + (size_t)modrow(half, r) * 6144 + (MODE == 0 ? 0 : 3072);
            bf16_t* dst = (bf16_t*)(p.ws + WS_H) + (size_t)r * 1024;
#pragma unroll
            for (int i = 0; i < 4; ++i) { const f32x4 sh = *(const f32x4*)(mr + i * 256 + lane * 4), sc = *(const f32x4*)(mr + 1024 + i * 256 + lane * 4);
                const f32x4 y = (v[i] * rstd * wq[i]) * (sc + 1.0f) + sh;
                u32x2 o; o.x = cvt_pk_bf16(y[0], y[1]); o.y = cvt_pk_bf16(y[2], y[3]); *(u32x2*)(dst + i * 256 + lane * 4) = o; }
        }
    }
}

template <int W>
__device__ __forceinline__ void pool_pass(const Params& p, int half, int lc, int grp, int lg, int lane) {
    const int ch = grp * 256 + lane * 4, l0 = lg * 8;
    const bool sample = lc >= 128, first = sample || lc == 0;
    const int sb = 16 * half + lc - 128;
    const int r0 = lc * 64, radd = sample ? 8192 + half * 1024 : half * 8192;
    const bf16_t* Pb = (const bf16_t*)p.out + (size_t)(r0 + l0 + radd) * 2048 + ch;
    float v[23][4];
#pragma unroll
    for (int i = 0; i < 23; ++i) { const int l = l0 - 15 + i;
        if (l >= 0 || !first) { const u32x2 w = *(const u32x2*)(Pb + (ptrdiff_t)(i - 15) * 2048); v[i][0] = bflo(w.x); v[i][1] = bfhi(w.x); v[i][2] = bflo(w.y); v[i][3] = bfhi(w.y); }
        else if (sample) { const f32x4 f = *(const f32x4*)(p.in[4] + ((size_t)sb * 15 + 15 + l) * 1024 + ch); v[i][0] = f[0]; v[i][1] = f[1]; v[i][2] = f[2]; v[i][3] = f[3]; }
        else { v[i][0] = v[i][1] = v[i][2] = v[i][3] = 0.f; } }
    float S[4] = {0.f, 0.f, 0.f, 0.f};
#pragma unroll
    for (int j = 0; j < W; ++j)
#pragma unroll
        for (int c = 0; c < 4; ++c) S[c] += v[15 - j][c];
    bf16_t* M = (bf16_t*)(p.ws + WS_H);
#pragma unroll
    for (int i = 0; i < 8; ++i) {
        if (i > 0) {
#pragma unroll
            for (int c = 0; c < 4; ++c) S[c] += v[15 + i][c] - v[15 + i - W][c]; }
        const int l = l0 + i; const int pos1 = sample ? 4097 + l : r0 + l + 1;
        const float rc = 1.0f / (float)(pos1 < W ? pos1 : W);
        u32x2 o; o.x = cvt_pk_bf16(S[0] * rc - v[15 + i][0], S[1] * rc - v[15 + i][1]); o.y = cvt_pk_bf16(S[2] * rc - v[15 + i][2], S[3] * rc - v[15 + i][3]);
        *(u32x2*)(M + (size_t)(r0 + l) * 1024 + ch) = o;
        if ((sample || lc == 127) && l >= 49) {
            float* op = sample ? p.out + O_POOLS + ((size_t)sb * 15 + (l - 49)) * 1024 + ch : p.out + O_POOLP + ((size_t)half * 15 + (l - 49)) * 1024 + ch;
            *(f32x4*)op = (f32x4){v[15 + i][0], v[15 + i][1], v[15 + i][2], v[15 + i][3]}; }
    }
}
__device__ __forceinline__ void s1_phase(const Params& p, int half, float* lds) {
    const int t0_ = otid(), bid = obid(); const int wid = __builtin_amdgcn_readfirstlane(t0_ >> 6);
    for (int item = bid; item < NCHK * 11; item += gridDim.x) {
        int t = t0_; asm volatile("" : "+v"(t)); const int lane = t & 63;
        const int lc = item / 11, sub = item % 11;
        const bool sample = lc >= 128, first = sample || lc == 0;
        const int sb = 16 * half + lc - 128;
        const int r0 = lc * 64;
        if (sub < 6) {
            const int lg = wid, l0 = lg * 8, col = sub * 512 + lane * 8;
            const bf16_t* Xb = (const bf16_t*)(p.ws + WS_X) + (size_t)(r0 + l0) * 3072 + col;
            float v[11][8];
#pragma unroll
            for (int i = 0; i < 11; ++i) { const int l = l0 - 3 + i;
                if (l >= 0 || !first) { const u32x4 w = *(const u32x4*)(Xb + (ptrdiff_t)(i - 3) * 3072);
                    v[i][0] = bflo(w.x); v[i][1] = bfhi(w.x); v[i][2] = bflo(w.y); v[i][3] = bfhi(w.y); v[i][4] = bflo(w.z); v[i][5] = bfhi(w.z); v[i][6] = bflo(w.w); v[i][7] = bfhi(w.w); }
                else if (sample) { const float* hp = p.in[5] + ((size_t)sb * 3 + 3 + l) * 3072 + col; const f32x4 f0 = *(const f32x4*)hp, f1 = *(const f32x4*)(hp + 4);
#pragma unroll
                    for (int c = 0; c < 4; ++c) { v[i][c] = f0[c]; v[i][4 + c] = f1[c]; } }
                else {
#pragma unroll
                    for (int c = 0; c < 8; ++c) v[i][c] = 0.f; } }
            if ((sample || lc == 127) && lg == 7) {
                float* o3 = sample ? p.out + O_CONVS + (size_t)sb * 3 * 3072 + col : p.out + O_CONVP + (size_t)half * 3 * 3072 + col;
#pragma unroll
                for (int k = 0; k < 3; ++k) { *(f32x4*)(o3 + (size_t)k * 3072) = (f32x4){v[8 + k][0], v[8 + k][1], v[8 + k][2], v[8 + k][3]}; *(f32x4*)(o3 + (size_t)k * 3072 + 4) = (f32x4){v[8 + k][4], v[8 + k][5], v[8 + k][6], v[8 + k][7]}; } }
            float wk[4][8], cbv[8];
#pragma unroll
            for (int k = 0; k < 4; ++k) { const f32x4 a0 = *(const f32x4*)(p.in[14] + (size_t)k * 3072 + col), a1 = *(const f32x4*)(p.in[14] + (size_t)k * 3072 + col + 4);
#pragma unroll
                for (int c = 0; c < 4; ++c) { wk[k][c] = a0[c]; wk[k][4 + c] = a1[c]; } }
            { const f32x4 a0 = *(const f32x4*)(p.in[15] + col), a1 = *(const f32x4*)(p.in[15] + col + 4);
#pragma unroll
                for (int c = 0; c < 4; ++c) { cbv[c] = a0[c]; cbv[4 + c] = a1[c]; } }
#pragma unroll
            for (int li = 0; li < 8; ++li)
#pragma unroll
                for (int c = 0; c < 8; ++c) v[li][c] = siluf_(cbv[c] + wk[0][c] * v[li][c] + wk[1][c] * v[li + 1][c] + wk[2][c] * v[li + 2][c] + wk[3][c] * v[li + 3][c]);
            if (sub >= 4) {
                const int ncol = col - (sub == 4 ? 2048 : 2560), g = ncol >> 7, n = ncol & 127;
                bf16_t* RM = (bf16_t*)(p.ws + (sub == 4 ? WS_BM : WS_CM)) + ((size_t)(lc * 4 + g) * 64 + l0) * 128 + n;
#pragma unroll
                for (int li = 0; li < 8; ++li) { u32x4 o; o.x = cvt_pk_bf16(v[li][0], v[li][1]); o.y = cvt_pk_bf16(v[li][2], v[li][3]); o.z = cvt_pk_bf16(v[li][4], v[li][5]); o.w = cvt_pk_bf16(v[li][6], v[li][7]);
                    *(u32x4*)(RM + (size_t)li * 128) = o; } }
            if (sub <= 4) {
                bf16_t* TB;
                if (sub < 4) { const int head = col >> 6, pp = col & 63; TB = (bf16_t*)(p.ws + WS_XT) + (((size_t)lc * 32 + head) * 64 + pp) * 64 + l0; }
                else { const int ncol = col - 2048, g = ncol >> 7, n = ncol & 127; TB = (bf16_t*)(p.ws + WS_BT) + ((size_t)(lc * 4 + g) * 128 + n) * 64 + l0; }
#pragma unroll
                for (int c = 0; c < 8; ++c) { u32x4 o; o.x = cvt_pk_bf16(v[0][c], v[1][c]); o.y = cvt_pk_bf16(v[2][c], v[3][c]); o.z = cvt_pk_bf16(v[4][c], v[5][c]); o.w = cvt_pk_bf16(v[6][c], v[7][c]);
                    *(u32x4*)(TB + (size_t)c * 64) = o; } }
        } else if (sub < 10) {
            const int grp = sub - 6;
            if (grp == 0) pool_pass<2>(p, half, lc, grp, wid, lane); else if (grp == 1) pool_pass<4>(p, half, lc, grp, wid, lane); else if (grp == 2) pool_pass<8>(p, half, lc, grp, wid, lane); else pool_pass<16>(p, half, lc, grp, wid, lane);
        } else {
            const int h = t & 31, lq = t >> 5;
            const float bias = p.in[16][h], A = -__expf(p.in[17][h]);
            const float* D = (const float*)(p.ws + WS_DTR);
            float dt[4], cs[4]; float run = 0.f;
#pragma unroll
            for (int j = 0; j < 4; ++j) { const float x = D[(size_t)(r0 + lq * 4 + j) * 32 + h] + bias; dt[j] = fmaxf(x, 0.f) + log1pf(__expf(-fabsf(x))); run += dt[j] * A; cs[j] = run; }
            __syncthreads();
            lds[lq * 32 + h] = run;
            __syncthreads();
            float base = 0.f;
            for (int k = 0; k < lq; ++k) base += lds[k * 32 + h];
            float* DT = (float*)(p.ws + WS_DTC) + ((size_t)lc * 32 + h) * 64 + lq * 4; float* AC = (float*)(p.ws + WS_ACS) + ((size_t)lc * 32 + h) * 64 + lq * 4;
            *(f32x4*)DT = (f32x4){dt[0], dt[1], dt[2], dt[3]}; *(f32x4*)AC = (f32x4){base + cs[0], base + cs[1], base + cs[2], base + cs[3]};
        }
    }
}

__device__ __forceinline__ bf16x8 pack8(const float* v) { u32x4 w; w.x = cvt_pk_bf16(v[0], v[1]); w.y = cvt_pk_bf16(v[2], v[3]); w.z = cvt_pk_bf16(v[4], v[5]); w.w = cvt_pk_bf16(v[6], v[7]); return __builtin_bit_cast(bf16x8, w); }
constexpr int SL_CM = 0, SL_CB = 64 * 272, SL_BT = SL_CB + 64 * 144, SL_AD = SL_BT + 128 * 144, SL_SIZE = SL_AD + 1024;
struct StageRegs { u32x4 r[5]; u32x4 ad; };
template <bool FULL>
__device__ __forceinline__ void stage_load(StageRegs& R, const unsigned char* ws, int lc, int g, int h0, int t) {
    if (FULL) {
        const u32x4* cm = (const u32x4*)(ws + WS_CM + (size_t)(lc * 4 + g) * 16384); R.r[0] = cm[t]; R.r[1] = cm[t + 512];
        R.r[2] = ((const u32x4*)(ws + WS_CB + (size_t)(lc * 4 + g) * 8192))[t]; }
    const u32x4* bt = (const u32x4*)(ws + WS_BT + (size_t)(lc * 4 + g) * 16384); R.r[3] = bt[t]; R.r[4] = bt[t + 512];
    if (t < 64) { const int e = t >> 5, part = (t >> 4) & 1, c = t & 15; R.ad = *(const u32x4*)(ws + (part ? WS_DTC : WS_ACS) + ((size_t)(lc * 32 + h0 + e) * 64) * 4 + c * 16); }
}
template <bool FULL>
__device__ __forceinline__ void stage_store(const StageRegs& R, LAS unsigned char* B, int t) {
    if (FULL) {
        *(LAS u32x4*)(B + SL_CM + (t >> 4) * 272 + (t & 15) * 16) = R.r[0]; *(LAS u32x4*)(B + SL_CM + (32 + (t >> 4)) * 272 + (t & 15) * 16) = R.r[1];
        *(LAS u32x4*)(B + SL_CB + (t >> 3) * 144 + (t & 7) * 16) = R.r[2]; }
    *(LAS u32x4*)(B + SL_BT + (t >> 3) * 144 + (t & 7) * 16) = R.r[3]; *(LAS u32x4*)(B + SL_BT + (64 + (t >> 3)) * 144 + (t & 7) * 16) = R.r[4];
    if (t < 64) *(LAS u32x4*)(B + SL_AD + t * 16) = R.ad;
}
struct XtRegs { bf16x8 xf[2]; bf16x4 xd[4]; };
template <bool FULL>
__device__ __forceinline__ void xt_load(XtRegs& X, const unsigned char* ws, int lc, int h, int pw, int c16, int q) {
    const bf16_t* XTp = (const bf16_t*)(ws + WS_XT) + (((size_t)lc * 32 + h) * 64 + pw + c16) * 64;
    X.xf[0] = *(const bf16x8*)(XTp + 8 * q); X.xf[1] = *(const bf16x8*)(XTp + 32 + 8 * q);
    if (FULL) {
#pragma unroll
        for (int lt = 0; lt < 4; ++lt) X.xd[lt] = *(const bf16x4*)(XTp + 16 * lt + 4 * q); }
}
template <bool FULL>
__device__ __forceinline__ void ssd_step(f32x4 (&H)[8], LAS unsigned char* B, int hsel, const XtRegs& X, unsigned char* ws, int lc, int h, int pw, int c16, int q, float dskip) {
    LAS unsigned char* AD = B + SL_AD + hsel * 512;
    float acs_k[16], dt_k[16];
#pragma unroll
    for (int kk = 0; kk < 2; ++kk) { const f32x4 a0 = *(LAS f32x4*)(AD + (32 * kk + 8 * q) * 4), a1 = *(LAS f32x4*)(AD + (32 * kk + 8 * q + 4) * 4), d0 = *(LAS f32x4*)(AD + 256 + (32 * kk + 8 * q) * 4), d1 = *(LAS f32x4*)(AD + 256 + (32 * kk + 8 * q + 4) * 4);
#pragma unroll
        for (int j = 0; j < 4; ++j) { acs_k[kk * 8 + j] = a0[j]; acs_k[kk * 8 + 4 + j] = a1[j]; dt_k[kk * 8 + j] = d0[j]; dt_k[kk * 8 + 4 + j] = d1[j]; } }
    const float acs63 = *(LAS float*)(AD + 63 * 4);
    if (FULL) {
        bf16_t* Y = (bf16_t*)(ws + WS_X);
        bf16x8 hf[4];
#pragma unroll
        for (int kk = 0; kk < 4; ++kk) { float tv[8];
#pragma unroll
            for (int j = 0; j < 4; ++j) { tv[j] = H[2 * kk][j]; tv[4 + j] = H[2 * kk + 1][j]; }
            hf[kk] = pack8(tv); }
#pragma unroll
        for (int lt = 0; lt < 4; ++lt) {
            const int l = 16 * lt + c16;
            bf16x8 cf[4], cb[2];
#pragma unroll
            for (int kk = 0; kk < 4; ++kk) cf[kk] = *(LAS bf16x8*)(B + SL_CM + l * 272 + (32 * kk + 8 * q) * 2);
#pragma unroll
            for (int kk = 0; kk < 2; ++kk) if (kk <= (lt >> 1)) cb[kk] = *(LAS bf16x8*)(B + SL_CB + l * 144 + (32 * kk + 8 * q) * 2);
            const f32x4 ad = *(LAS f32x4*)(AD + (16 * lt + 4 * q) * 4);
            const float arow = *(LAS float*)(AD + l * 4);
            f32x4 y = {0.f, 0.f, 0.f, 0.f};
#pragma unroll
            for (int kk = 0; kk < 4; ++kk) y = __builtin_amdgcn_mfma_f32_16x16x32_bf16(cf[kk], hf[kk], y, 0, 0, 0);
#pragma unroll
            for (int i = 0; i < 4; ++i) y[i] *= __expf(ad[i]);
#pragma unroll
            for (int kk = 0; kk < 2; ++kk) if (kk <= (lt >> 1)) { float lm[8];
#pragma unroll
                for (int j = 0; j < 8; ++j) { const int s_ = 32 * kk + 8 * q + j; lm[j] = (s_ <= l) ? bf2f(cb[kk][j]) * __expf(arow - acs_k[kk * 8 + j]) * dt_k[kk * 8 + j] : 0.f; }
                y = __builtin_amdgcn_mfma_f32_16x16x32_bf16(pack8(lm), X.xf[kk], y, 0, 0, 0); }
#pragma unroll
            for (int i = 0; i < 4; ++i) { const float yv = y[i] + dskip * bf2f(X.xd[lt][i]);
                Y[(size_t)(lc * 64 + 16 * lt + 4 * q + i) * 2048 + h * 64 + pw + c16] = (bf16_t)(cvt_pk_bf16(yv, 0.f) & 0xffffu); }
        }
    }
    const float dec = __expf(acs63);
    bf16x8 xw[2];
#pragma unroll
    for (int kk = 0; kk < 2; ++kk) { float tv[8];
#pragma unroll
        for (int j = 0; j < 8; ++j) tv[j] = bf2f(X.xf[kk][j]) * dt_k[kk * 8 + j] * __expf(acs63 - acs_k[kk * 8 + j]);
        xw[kk] = pack8(tv); }
    const int nlane = 8 * (c16 >> 2) + (c16 & 3);
#pragma unroll
    for (int np = 0; np < 4; ++np) {
        bf16x8 bt[2][2];
#pragma unroll
        for (int e = 0; e < 2; ++e)
#pragma unroll
            for (int kk = 0; kk < 2; ++kk) bt[e][kk] = *(LAS bf16x8*)(B + SL_BT + (32 * np + nlane + 4 * e) * 144 + (32 * kk + 8 * q) * 2);
#pragma unroll
        for (int e = 0; e < 2; ++e) { H[2 * np + e] *= dec;
#pragma unroll
            for (int kk = 0; kk < 2; ++kk) H[2 * np + e] = __builtin_amdgcn_mfma_f32_16x16x32_bf16(bt[e][kk], xw[kk], H[2 * np + e], 0, 0, 0); } }
}
template <bool FULL>
__device__ __forceinline__ void ssd_walk(f32x4 (&H)[8], LAS unsigned char* lds, unsigned char* ws, int lc0, int nsteps, int h0, int t, int quad, int pw, int c16, int q, float dskip) {
    const int g = h0 >> 3, h = h0 + quad;
    StageRegs R; XtRegs Xn, X;
    stage_load<FULL>(R, ws, lc0, g, h0, t); xt_load<FULL>(Xn, ws, lc0, h, pw, c16, q);
    stage_store<FULL>(R, lds, t);
    __syncthreads();
#pragma unroll 1
    for (int c = 0; c < nsteps; ++c) {
        X = Xn;
        const bool more = c + 1 < nsteps;
        if (more) { stage_load<FULL>(R, ws, lc0 + c + 1, g, h0, t); xt_load<FULL>(Xn, ws, lc0 + c + 1, h, pw, c16, q); }
        ssd_step<FULL>(H, lds + (c & 1) * SL_SIZE, quad, X, ws, lc0 + c, h, pw, c16, q, dskip);
        if (more) stage_store<FULL>(R, lds + ((c + 1) & 1) * SL_SIZE, t);
        __syncthreads();
    }
}
__device__ __forceinline__ int n0_of(int nt, int q) { return 32 * (nt >> 1) + 8 * q + 4 * (nt & 1); }
__device__ __forceinline__ void cb_item(const unsigned char* ws, int idx, int w4, int c16, int q) {
    const bf16_t* Bp = (const bf16_t*)(ws + WS_BM) + (size_t)idx * 64 * 128; const bf16_t* Cp = (const bf16_t*)(ws + WS_CM) + (size_t)idx * 64 * 128;
    bf16_t* O = (bf16_t*)(ws + WS_CB) + (size_t)idx * 64 * 64;
    const int lt = w4;
    bf16x8 cf[4];
#pragma unroll
    for (int kk = 0; kk < 4; ++kk) cf[kk] = *(const bf16x8*)(Cp + (size_t)(16 * lt + c16) * 128 + 32 * kk + 8 * q);
    for (int st = 0; st <= lt; ++st) { f32x4 d = {0.f, 0.f, 0.f, 0.f};
#pragma unroll
        for (int kk = 0; kk < 4; ++kk) { const bf16x8 bfr = *(const bf16x8*)(Bp + (size_t)(16 * st + c16) * 128 + 32 * kk + 8 * q); d = __builtin_amdgcn_mfma_f32_16x16x32_bf16(bfr, cf[kk], d, 0, 0, 0); }
        u32x2 o; o.x = cvt_pk_bf16(d[0], d[1]); o.y = cvt_pk_bf16(d[2], d[3]);
        *(u32x2*)(O + (size_t)(16 * lt + c16) * 64 + 16 * st + 4 * q) = o; }
}
__device__ __forceinline__ void mix1_quads(const Params& p, int half, LAS unsigned char* lds) {
    const int t = otid(), bid = obid(); const int wid = __builtin_amdgcn_readfirstlane(t >> 6), lane = t & 63, quad = wid >> 2, w4 = wid & 3, c16 = lane & 15, q = lane >> 4, pw = w4 * 16;
    for (int item = bid; item < 240; item += gridDim.x) { const int k = item >> 4, h0 = (item & 15) * 2;
        f32x4 H[8];
#pragma unroll
        for (int nt = 0; nt < 8; ++nt) H[nt] = (f32x4){0.f, 0.f, 0.f, 0.f};
        ssd_walk<false>(H, lds, p.ws, 8 * k, 8, h0, t, quad, pw, c16, q, 0.f);
        float* ST = (float*)(p.ws + WS_ST) + (((size_t)k * 32 + h0 + quad) * 64 + pw + c16) * 128;
#pragma unroll
        for (int nt = 0; nt < 8; ++nt) *(f32x4*)(ST + n0_of(nt, q)) = H[nt];
    }
    for (int item = (gridDim.x - 1 - bid) * 2 + quad; item < NCHK * 4; item += gridDim.x * 2) cb_item(p.ws, item, w4, c16, q);
}
__device__ __forceinline__ void passb(const Params& p) {
    const int vb = gridDim.x - 1 - obid(); const int t_ = otid();
    for (int v = vb * 512 + t_; v < 65536; v += gridDim.x * 512) {
        const int h = v >> 11; f32x4 carry = {0.f, 0.f, 0.f, 0.f};
        float* ST = (float*)(p.ws + WS_ST) + (size_t)v * 4; const float* AC = (const float*)(p.ws + WS_ACS);
        for (int k = 0; k < 15; ++k) { float a = 0.f;
#pragma unroll
            for (int c = 0; c < 8; ++c) a += AC[((size_t)(8 * k + c) * 32 + h) * 64 + 63];
            const f32x4 s = *(const f32x4*)(ST + (size_t)k * 262144); carry = carry * __expf(a) + s; *(f32x4*)(ST + (size_t)k * 262144) = carry; }
    }
}
__device__ __forceinline__ void passc(const Params& p, int half, LAS unsigned char* lds) {
    const int t = otid(), bid = obid(); const int wid = __builtin_amdgcn_readfirstlane(t >> 6), lane = t & 63, quad = wid >> 2, w4 = wid & 3, c16 = lane & 15, q = lane >> 4, pw = w4 * 16;
    for (int item = bid; item < 256; item += gridDim.x) {
    const int h0 = (item & 15) * 2, h = h0 + quad; const float dskip = p.in[18][h];
    f32x4 H[8];
    { const int k = item >> 4;
        if (k == 0) {
#pragma unroll
            for (int nt = 0; nt < 8; ++nt) H[nt] = (f32x4){0.f, 0.f, 0.f, 0.f};
        } else { const float* ST = (const float*)(p.ws + WS_ST) + (((size_t)(k - 1) * 32 + h) * 64 + pw + c16) * 128;
#pragma unroll
            for (int nt = 0; nt < 8; ++nt) H[nt] = *(const f32x4*)(ST + n0_of(nt, q)); }
        ssd_walk<true>(H, lds, p.ws, 8 * k, 8, h0, t, quad, pw, c16, q, dskip);
        if (k == 15) { float* O = p.out + O_SSMP + (((size_t)half * 32 + h) * 64 + pw + c16) * 128;
#pragma unroll
            for (int nt = 0; nt < 8; ++nt) *(f32x4*)(O + n0_of(nt, q)) = H[nt]; } }
    { const int sbl = item >> 4, sb = 16 * half + sbl;
        const float* S0 = p.in[6] + (((size_t)sb * 32 + h) * 64 + pw + c16) * 128;
#pragma unroll
        for (int nt = 0; nt < 8; ++nt) H[nt] = *(const f32x4*)(S0 + n0_of(nt, q));
        ssd_walk<true>(H, lds, p.ws, 128 + sbl, 1, h0, t, quad, pw, c16, q, dskip);
        float* O = p.out + O_SSMS + (((size_t)sb * 32 + h) * 64 + pw + c16) * 128;
#pragma unroll
        for (int nt = 0; nt < 8; ++nt) *(f32x4*)(O + n0_of(nt, q)) = H[nt]; }
    }
}
__device__ __forceinline__ void s5_phase(const Params& p) {
    const int t_ = otid(), bid = obid(); const int lane = t_ & 63, wv = t_ >> 6;
    for (int r = bid * 8 + wv; r < HR; r += gridDim.x * 8) {
        bf16_t* Y = (bf16_t*)(p.ws + WS_X) + (size_t)r * 2048; const bf16_t* Z = (const bf16_t*)(p.ws + WS_Z) + (size_t)r * 2048;
#pragma unroll
        for (int g = 0; g < 4; ++g) { const int c = g * 512 + lane * 8;
            const u32x4 yv = *(const u32x4*)(Y + c), zv = *(const u32x4*)(Z + c);
            const unsigned yw[4] = {yv.x, yv.y, yv.z, yv.w}, zw[4] = {zv.x, zv.y, zv.z, zv.w};
            float v[8]; float ss = 0.f;
#pragma unroll
            for (int j = 0; j < 4; ++j) { v[2 * j] = bflo(yw[j]) * siluf_(bflo(zw[j])); v[2 * j + 1] = bfhi(yw[j]) * siluf_(bfhi(zw[j])); ss += v[2 * j] * v[2 * j] + v[2 * j + 1] * v[2 * j + 1]; }
            ss = wave_sum(ss);
            const float rstd = rsqrtf(ss * (1.0f / 512.0f) + 1e-6f);
            const f32x4 w0 = *(const f32x4*)(p.in[19] + c), w1 = *(const f32x4*)(p.in[19] + c + 4);
            u32x4 o; o.x = cvt_pk_bf16(v[0] * rstd * w0[0], v[1] * rstd * w0[1]); o.y = cvt_pk_bf16(v[2] * rstd * w0[2], v[3] * rstd * w0[3]);
            o.z = cvt_pk_bf16(v[4] * rstd * w1[0], v[5] * rstd * w1[1]); o.w = cvt_pk_bf16(v[6] * rstd * w1[2], v[7] * rstd * w1[3]);
            *(u32x4*)(Y + c) = o; }
    }
}

__device__ __forceinline__ void g_in(const Params& p, int half, LAS unsigned char* lds) { unsigned char* ws = p.ws; pg8::StaticOrder S;
    pg8::Gemm g{(const bf16_t*)(ws + WS_H), (const bf16_t*)(ws + WS_WIN), HR, NINP, 1024, 1024, 1024, 0}; S.init(HR, NINP, gridDim.x, obid());
    EpiIn E{ws, p.out, half}; pg8::gemm_phase(lds, g, S, E); }
__device__ __forceinline__ void g_pool(const Params& p, int half, LAS unsigned char* lds) { unsigned char* ws = p.ws; pg8::StaticOrder S;
    pg8::Gemm g{(const bf16_t*)(ws + WS_H), (const bf16_t*)(ws + WS_WGRP), HR, 1024, 256, 1024, 256, 256}; S.init(HR, 1024, gridDim.x, obid());
    EpiPool E{(bf16_t*)(ws + WS_AM), p.in[13]}; pg8::gemm_phase(lds, g, S, E); }
__device__ __forceinline__ void g_a(const Params& p, int half, LAS unsigned char* lds) { unsigned char* ws = p.ws; pg8::StaticOrder S;
    pg8::Gemm g{(const bf16_t*)(ws + WS_AM), (const bf16_t*)(ws + WS_WA), HR, 1024, 1024, 1024, 1024, 0}; S.init(HR, 1024, gridDim.x, obid());
    EpiA E{(bf16_t*)(ws + WS_H), (const bf16_t*)p.out + 1024, half}; pg8::gemm_phase(lds, g, S, E); }
__device__ __forceinline__ void g_b(const Params& p, int half, LAS unsigned char* lds) { unsigned char* ws = p.ws; pg8::StaticOrder S;
    pg8::Gemm g{(const bf16_t*)(ws + WS_X), (const bf16_t*)(ws + WS_WB), HR, 1024, 2048, 2048, 2048, 0}; S.init(HR, 1024, gridDim.x, obid());
    EpiB E{(bf16_t*)(ws + WS_GB), (const bf16_t*)(ws + WS_H)}; pg8::gemm_phase(lds, g, S, E); }
__device__ __forceinline__ void g_out(const Params& p, int half, LAS unsigned char* lds) { unsigned char* ws = p.ws; pg8::StaticOrder S;
    pg8::Gemm g{(const bf16_t*)(ws + WS_GB), (const bf16_t*)(ws + WS_WOUT), HR, 1024, 1024, 1024, 1024, 0}; S.init(HR, 1024, gridDim.x, obid());
    EpiRes E{p.out, p.in[0], p.in[1], (const float*)(ws + WS_MOD), 2048, half, 0}; pg8::gemm_phase(lds, g, S, E); }
__device__ __forceinline__ void g_f1(const Params& p, int half, LAS unsigned char* lds) { unsigned char* ws = p.ws; pg8::StaticOrder S;
    pg8::Gemm g{(const bf16_t*)(ws + WS_H), (const bf16_t*)(ws + WS_WF1), HR, 5632, 1024, 1024, 1024, 0}; S.init(HR, 5632, gridDim.x, obid());
    EpiF1 E{(bf16_t*)(ws + WS_X)}; pg8::gemm_phase(lds, g, S, E); }
__device__ __forceinline__ void g_f2(const Params& p, int half, LAS unsigned char* lds) { unsigned char* ws = p.ws; pg8::StaticOrder S;
    pg8::Gemm g{(const bf16_t*)(ws + WS_X), (const bf16_t*)(ws + WS_WF2), HR, 1024, DFF, DFF, DFF, 0}; S.init(HR, 1024, gridDim.x, obid());
    EpiRes E{p.out, p.in[0], p.in[1], (const float*)(ws + WS_MOD), 5120, half, 1}; pg8::gemm_phase(lds, g, S, E); }

__global__ void __launch_bounds__(512, 2) mega(Params p) {
    extern __shared__ __attribute__((aligned(16))) unsigned char shm[];
    LAS unsigned char* lds = (LAS unsigned char*)shm;
    volatile LAS unsigned* stw = (volatile LAS unsigned*)(lds + 131072);
    if (threadIdx.x == 0) { stw[0] = 0u; stw[1] = 0u; }
    __syncthreads();
    const XcdBarrier xb = xcd_barrier_post((unsigned*)(p.ws + WS_BAR), stw);
    for (int ph = p.ph_lo; ph < p.ph_hi; ++ph) {
        if (ph > p.ph_lo) { if (ph == 1) cg::this_grid().sync(); else if (ph != 14) xcd_barrier(xb); else __syncthreads(); }
        if (REPEAT_SP == 200 && ph == 1) { for (int zz = 0; zz < 20; ++zz) cg::this_grid().sync(); }
        if (ph == 0) { phase0(p, (float*)shm); if (REPEAT_SP == 100) { __syncthreads(); phase0(p, (float*)shm); } continue; }
        if (ph == 27) {
            const size_t i0 = (size_t)obid() * 512 + otid(), st = (size_t)gridDim.x * 512;
            if (DIAG_K < 0) { for (size_t i = i0; i < (size_t)28622848; i += st) { const float v = p.out[i]; if (!(fabsf(v) < 1e30f)) p.out[i] = 0.f; } }
            else {
                for (size_t i = i0; i < (size_t)18874368; i += st) { float a = 0.f;
#define DBF(off, n) { const float v = bf2f((short)((const bf16_t*)(p.ws + (off)))[i % (size_t)(n)]); a += (fabsf(v) < 1e30f) ? v : 777.f; }
#define DF32(off, n) { const float v = ((const float*)(p.ws + (off)))[i % (size_t)(n)]; a += (fabsf(v) < 1e30f) ? v : 777.f; }
                    DF32(WS_MOD, 34 * 6144)
                    if (DIAG_K == 0) { DBF(WS_H, HR * 1024) DBF(WS_WIN, NINP * 1024) DBF(WS_WGRP, 1024 * 256) DBF(WS_WA, 1024 * 1024) DBF(WS_WB, 2048 * 1024) DBF(WS_WOUT, 1024 * 1024) DBF(WS_WF1, 5632 * 1024) DBF(WS_WF2, 2816 * 1024) }
                    if (DIAG_K == 1) { DBF(WS_H, HR * 1024) DBF(WS_Z, HR * 2048) DBF(WS_X, HR * 3072) DBF(WS_GB, HR * 1024) DF32(WS_DTR, HR * 32) }
                    if (DIAG_K == 2) { DBF(WS_H, HR * 1024) DBF(WS_XT, HR * 2048) DBF(WS_BT, NCHK * 4 * 128 * 64) DBF(WS_CM, NCHK * 4 * 128 * 64) DBF(WS_BM, NCHK * 4 * 128 * 64) DF32(WS_DTC, HR * 32) DF32(WS_ACS, HR * 32) }
                    if (DIAG_K == 3) { DBF(WS_AM, HR * 1024) DF32(WS_ST, 15 * 32 * 64 * 128) }
                    if (DIAG_K == 4) { DBF(WS_H, HR * 1024) DF32(WS_ST, 15 * 32 * 64 * 128) }
                    if (DIAG_K == 5 || DIAG_K == 6) { DBF(WS_X, HR * 2048) }
                    if (DIAG_K == 7) { DBF(WS_GB, HR * 1024) }
                    p.out[i] = a; }
                if (DIAG_K < 5) for (size_t i = i0; i < (size_t)524288; i += st) p.out[O_SSMP + i] = 0.f;
                if (DIAG_K < 5) for (size_t i = i0; i < (size_t)8388608; i += st) p.out[O_SSMS + i] = 0.f;
                if (DIAG_K < 2) for (size_t i = i0; i < (size_t)(O_SSMP - O_POOLP); i += st) p.out[O_POOLP + i] = 0.f;
                if (DIAG_K < 2) for (size_t i = i0; i < (size_t)(O_SSMS - O_POOLS); i += st) p.out[O_POOLS + i] = 0.f;
            }
            continue; }
        const int half = (ph - 1) / 13, sp = (ph - 1) % 13;
        if (DIAG_K >= 0 && sp > DIAG_K) continue;
        switch (sp) {
        case 0: norm_phase<0>(p, half); break;
        case 1: g_in(p, half, lds); if (REPEAT_SP == 1) { __syncthreads(); g_in(p, half, lds); } break;
        case 2: s1_phase(p, half, (float*)shm); break;
        case 3: g_pool(p, half, lds); mix1_quads(p, half, lds); break;
        case 4: g_a(p, half, lds); passb(p); break;
        case 5: passc(p, half, lds); break;
        case 6: s5_phase(p); break;
        case 7: g_b(p, half, lds); break;
        case 8: g_out(p, half, lds); break;
        case 9: norm_phase<1>(p, half); break;
        case 10: g_f1(p, half, lds); break;
        case 11: g_f2(p, half, lds); break;
        default: norm_phase<2>(p, half); break;
        }
    }
}

extern "C" void kernel_launch(void* const* d_in, const int* in_sizes, int n_in, void* d_out, int out_size, void* d_ws, size_t ws_size, hipStream_t stream) {
    static int grid = 0;
    if (grid == 0) {
        int dev = 0, cus = 0, per_cu = 0;
        (void)hipGetDevice(&dev);
        (void)hipDeviceGetAttribute(&cus, hipDeviceAttributeMultiprocessorCount, dev);
        if (hipFuncSetAttribute((const void*)mega, hipFuncAttributeMaxDynamicSharedMemorySize, LDS_BYTES) != hipSuccess) { fprintf(stderr, "hipFuncSetAttribute failed\n"); grid = -1; return; }
        if (hipOccupancyMaxActiveBlocksPerMultiprocessor(&per_cu, (const void*)mega, 512, LDS_BYTES) != hipSuccess || per_cu < 1) { fprintf(stderr, "occupancy query failed (%d)\n", per_cu); (void)hipGetLastError(); per_cu = 1; }
        grid = cus * 1;
        if (ws_size < WS_END) { fprintf(stderr, "workspace too small: %zu < %zu\n", ws_size, (size_t)WS_END); grid = -1; return; }
    }
    if (grid < 0) return;
    if (hipMemsetAsync((char*)d_ws + WS_BAR, 0, 16384, stream) != hipSuccess) { fprintf(stderr, "memset of barrier words failed\n"); return; }
    Params p{};
    for (int i = 0; i < 27; ++i) p.in[i] = (const float*)d_in[i];
    p.out = (float*)d_out; p.ws = (unsigned char*)d_ws;
#if MULTI_LAUNCH
    for (int ph = 0; ph < NPHASE; ++ph) { p.ph_lo = ph; p.ph_hi = ph + 1; hipLaunchKernelGGL(mega, dim3(grid), dim3(512), LDS_BYTES, stream, p); }
#else
    p.ph_lo = 0; p.ph_hi = NPHASE;
    void* args[] = {&p};
    hipError_t e = hipLaunchCooperativeKernel((const void*)mega, dim3(grid), dim3(512), args, LDS_BYTES, stream);
    if (e != hipSuccess) fprintf(stderr, "cooperative launch failed: %s (grid %d)\n", hipGetErrorString(e), grid);
#endif
}
```

```cpp
#include <hip/hip_runtime.h>
#include <hip/hip_cooperative_groups.h>
#include <cstdio>
namespace cg = cooperative_groups;

#ifndef MULTI_LAUNCH
#define MULTI_LAUNCH 0
#endif

#define LAS __attribute__((address_space(3)))
typedef unsigned short bf16_t;
typedef short bf16x8 __attribute__((ext_vector_type(8)));
typedef short bf16x4 __attribute__((ext_vector_type(4)));
typedef float f32x4 __attribute__((ext_vector_type(4)));
typedef float f32x2 __attribute__((ext_vector_type(2)));
typedef unsigned u32x4 __attribute__((ext_vector_type(4)));
typedef unsigned u32x2 __attribute__((ext_vector_type(2)));

constexpr int DM = 1024, HR = 9216  , NCHK = 144  ;
constexpr int NH = 32, DFF = 2816, NIN = 8224, NINP = 8448;
constexpr int LDS_BYTES = 131072 + 16;
#ifndef REPEAT_SP
#define REPEAT_SP -1
#endif
#ifndef DIAG_K
#define DIAG_K -1
#endif
#ifndef SANITIZE
#define SANITIZE 0
#endif
constexpr int NPHASE = 27 + SANITIZE;

constexpr size_t WS_WIN = 0;
constexpr size_t WS_WGRP = WS_WIN + (size_t)NINP * 1024 * 2;
constexpr size_t WS_WA = WS_WGRP + (size_t)1024 * 256 * 2;
constexpr size_t WS_WB = WS_WA + (size_t)1024 * 1024 * 2;
constexpr size_t WS_WOUT = WS_WB + (size_t)1024 * 2048 * 2;
constexpr size_t WS_WF1 = WS_WOUT + (size_t)1024 * 1024 * 2;
constexpr size_t WS_WF2 = WS_WF1 + (size_t)5632 * 1024 * 2;
constexpr size_t WS_MOD = WS_WF2 + (size_t)1024 * 2816 * 2;
constexpr size_t WS_H = WS_MOD + (size_t)34 * 6144 * 4;
constexpr size_t WS_Z = WS_H + (size_t)HR * 1024 * 2;
constexpr size_t WS_X = WS_Z + (size_t)HR * 2048 * 2;
constexpr size_t WS_AM = WS_X + (size_t)HR * 2048 * 2;
constexpr size_t WS_GB = WS_X + (size_t)HR * 3072 * 2;
constexpr size_t WS_XT = WS_GB + (size_t)HR * 1024 * 2;
constexpr size_t WS_BT = WS_XT + (size_t)HR * 2048 * 2;
constexpr size_t WS_CM = WS_BT + (size_t)NCHK * 4 * 128 * 64 * 2;
constexpr size_t WS_BM = WS_CM + (size_t)NCHK * 4 * 128 * 64 * 2;
constexpr size_t WS_CB = WS_BM + (size_t)NCHK * 4 * 128 * 64 * 2;
constexpr size_t WS_ST = WS_CB + (size_t)NCHK * 4 * 64 * 64 * 2;
constexpr size_t WS_DTR = WS_ST + (size_t)15 * 32 * 64 * 128 * 4;
constexpr size_t WS_DTC = WS_DTR + (size_t)HR * 32 * 4;
constexpr size_t WS_ACS = WS_DTC + (size_t)HR * 32 * 4;
constexpr size_t WS_BAR = WS_ACS + (size_t)HR * 32 * 4;
constexpr size_t WS_END = WS_BAR + 16384;
static_assert(WS_END <= (size_t)256 * 1024 * 1024, "workspace");

constexpr size_t O_Y = 0;
constexpr size_t O_POOLP = 18874368;
constexpr size_t O_CONVP = O_POOLP + 30720;
constexpr size_t O_SSMP = O_CONVP + 18432;
constexpr size_t O_POOLS = O_SSMP + 524288;
constexpr size_t O_CONVS = O_POOLS + 491520;
constexpr size_t O_SSMS = O_CONVS + 294912;

struct Params {
    const float* in[27];
    float* out;
    unsigned char* ws;
    int ph_lo, ph_hi;
};

typedef __bf16 bfx2_t __attribute__((ext_vector_type(2)));
__device__ __forceinline__ unsigned cvt_pk_bf16(float lo, float hi) { const f32x2 v = {lo, hi}; return __builtin_bit_cast(unsigned, __builtin_convertvector(v, bfx2_t)); }
__device__ __forceinline__ float bf2f(short b) { return __uint_as_float(((unsigned)(unsigned short)b) << 16); }
__device__ __forceinline__ float bflo(unsigned w) { return __uint_as_float(w << 16); }
__device__ __forceinline__ float bfhi(unsigned w) { return __uint_as_float(w & 0xffff0000u); }
__device__ __forceinline__ float sigmoidf_(float x) { return 1.0f / (1.0f + __expf(-x)); }
__device__ __forceinline__ float siluf_(float x) { return x / (1.0f + __expf(-x)); }
__device__ __forceinline__ int segoff(int half, int pm) { return pm < 32 ? half * 8192 : 8192 + half * 1024; }
__device__ __forceinline__ int gtok(int half, int r) { return r + (r < 8192 ? half * 8192 : 8192 + half * 1024); }
__device__ __forceinline__ int modrow(int half, int r) { return r < 8192 ? half : 2 + 16 * half + ((r - 8192) >> 6); }
__device__ __forceinline__ int otid() { int t = threadIdx.x; asm volatile("" : "+v"(t)); return t; }
__device__ __forceinline__ int obid() { int b = blockIdx.x; asm volatile("" : "+s"(b)); return b; }
__device__ __forceinline__ float wave_sum(float v) {
#pragma unroll
    for (int o = 32; o > 0; o >>= 1) v += __shfl_xor(v, o, 64);
    return v;
}

#define XB_TMO      128
#define XB_XCNT(j)  (256  + 64 * (j))
#define XB_XSUB(j)  (1280 + 64 * (j))
#define XB_XGEN(j)  (2304 + 64 * (j))
#define XB_TOP      3328
#define XB_TOPGEN   3392
#define XCD_BAR_WORDS 3456
#define XB_SPIN_CAP (1u << 18)

__device__ __forceinline__ unsigned xb_ld(unsigned* p)              { return __hip_atomic_load(p, __ATOMIC_RELAXED, __HIP_MEMORY_SCOPE_AGENT); }
__device__ __forceinline__ unsigned xb_add(unsigned* p, unsigned v) { return __hip_atomic_fetch_add(p, v, __ATOMIC_RELAXED, __HIP_MEMORY_SCOPE_AGENT); }
__device__ __forceinline__ unsigned xb_xcc_id() { return (unsigned)__builtin_amdgcn_s_getreg((3 << 11) | 20) & 0xFu; }
#define XB_SPIN(cond, bar) do { unsigned _sp = 0; while (cond) { __builtin_amdgcn_s_sleep(1); \
    if ((++_sp & 255u) == 0u) { if (xb_ld(&(bar)[XB_TMO])) break; if (_sp > XB_SPIN_CAP) { atomicAdd(&(bar)[XB_TMO], 1u); break; } } } } while (0)

struct XcdBarrier {
    unsigned* bar; unsigned x;
    volatile LAS unsigned* st;
};

__device__ __forceinline__ XcdBarrier xcd_barrier_post(unsigned* bar, volatile LAS unsigned* st) {
    XcdBarrier b; b.bar = bar; b.x = xb_xcc_id(); b.st = st;
    if (threadIdx.x == 0) (void)xb_add(&bar[XB_XCNT(b.x)], 1u);
    return b;
}
__device__ __forceinline__ void xcd_barrier_complete(unsigned* bar, unsigned x, unsigned& nloc, unsigned& nx) {
    const unsigned G = gridDim.x * gridDim.y * gridDim.z;
    unsigned sum, cnt, mine, sp = 0u;
    for (;;) {
        sum = 0u; cnt = 0u; mine = 0u;
#pragma unroll
        for (unsigned j = 0; j < 16; ++j) { const unsigned c = xb_ld(&bar[XB_XCNT(j)]); sum += c; cnt += (c > 0u) ? 1u : 0u; mine = (j == x) ? c : mine; }
        if (sum == G) break;
        __builtin_amdgcn_s_sleep(1);
        if ((++sp & 255u) == 0u) { if (xb_ld(&bar[XB_TMO])) break; if (sp > XB_SPIN_CAP) { atomicAdd(&bar[XB_TMO], 1u); break; } }
    }
    nloc = mine > 0u ? mine : 1u; nx = cnt > 0u ? cnt : 1u;
}

__device__ __forceinline__ void xcd_barrier(const XcdBarrier& b) {
    asm volatile("s_waitcnt vmcnt(0)" ::: "memory");
    __syncthreads();
    if (threadIdx.x == 0) {
        unsigned* bar = b.bar;
        __builtin_amdgcn_s_waitcnt(0);
        unsigned nloc = b.st[0], nx = b.st[1];
        if (nloc == 0u) { xcd_barrier_complete(bar, b.x, nloc, nx); b.st[0] = nloc; b.st[1] = nx; }
        const unsigned old = xb_add(&bar[XB_XSUB(b.x)], 1u);
        const unsigned gen = old / nloc;
        if (old + 1u == (gen + 1u) * nloc) {
            __builtin_amdgcn_fence(__ATOMIC_RELEASE, "agent");
            asm volatile("s_waitcnt vmcnt(0)" ::: "memory");
            const unsigned og = xb_add(&bar[XB_TOP], 1u);
            const unsigned tg = og / nx;
            if (og + 1u == (tg + 1u) * nx) xb_add(&bar[XB_TOPGEN], 1u);
            else XB_SPIN(xb_ld(&bar[XB_TOPGEN]) == tg, bar);
            __builtin_amdgcn_fence(__ATOMIC_ACQUIRE, "agent");
            xb_add(&bar[XB_XGEN(b.x)], 1u);
            asm volatile("s_waitcnt vmcnt(0)" ::: "memory");
        } else {
            XB_SPIN(xb_ld(&bar[XB_XGEN(b.x)]) == gen, bar);
            __builtin_amdgcn_fence(__ATOMIC_ACQUIRE, "agent");
            asm volatile("s_waitcnt vmcnt(0)" ::: "memory");
        }
    }
    __syncthreads();
}


namespace pg8 {
constexpr int BM = 256, BK = 64, HALF = 128, HTB = HALF * BK * 2, STAGE_BYTES = 8 * HTB, NXCD = 8, WGM = 8;
__device__ __forceinline__ int lds_byte(int r, int c) { const int st = (r >> 4) * 2 + (c >> 5), rr = r & 15, cc = c & 31, ob = rr * 64 + cc * 2; return st * 1024 + (ob ^ (((ob >> 9) & 1) << 5)); }
__device__ __forceinline__ void stage_rc(int b, int& R, int& C) { const int st = b / 1024, sb = b % 1024, swz = sb ^ (((sb >> 9) & 1) << 5); R = (st >> 1) * 16 + swz / 64; C = (st & 1) * 32 + (swz % 64) / 2; }
__device__ __forceinline__ int perm32(int rho) { const int n = rho >> 4, i = rho & 15; return 8 * (i >> 2) + 4 * n + (i & 3); }
struct Unit { int pm, pn; };
struct Gemm { const bf16_t* A; const bf16_t* Bt; int M, N, K, lda, ldb, acoff; };
struct StaticOrder {
    int nM, nN, nwg, G, c;
    __device__ void init(int M, int N, int G_, int c_) { nM = M / BM; nN = N / BM; nwg = nM * nN; G = G_; c = c_; }
    __device__ bool next(int i, Unit& u) const {
        const long L = (long)i * G + c; if (L >= nwg) return false;
        int wgid = (int)L; { const int q = nwg / NXCD, r = nwg % NXCD, xcd = wgid % NXCD, off = wgid / NXCD; wgid = (xcd < r ? xcd * (q + 1) : r * (q + 1) + (xcd - r) * q) + off; }
        const int nig = WGM * nN, gid = wgid / nig, fm = gid * WGM, gsz = (nM - fm) < WGM ? (nM - fm) : WGM;
        u.pm = fm + ((wgid % nig) % gsz); u.pn = (wgid % nig) / gsz; return true;
    }
};

template <class Epi>
__device__ __forceinline__ void gemm_phase(LAS unsigned char* lds, const Gemm g, const StaticOrder& S, const Epi& E) {
    const int tid = otid(), wid = __builtin_amdgcn_readfirstlane(tid >> 6), lane = tid & 63, wr = wid >> 2, wc = wid & 3, fr = lane & 15, fq = lane >> 4;
    const int nt = g.K / BK;
    unsigned voffA[2], voffB[2];
#pragma unroll
    for (int i = 0; i < 2; ++i) { int R, C; stage_rc(tid * 16 + i * 8192, R, C); const int Rb = Epi::PERM ? ((R & ~31) + perm32(R & 31)) : R;
        voffA[i] = (unsigned)(R * g.lda + C) * 2u; voffB[i] = (unsigned)(Rb * g.ldb + C) * 2u; }
    const size_t kstep = (size_t)(BK * 2);
    const size_t hstepA = (size_t)HALF * g.lda * 2, hstepB = (size_t)HALF * g.ldb * 2;
    const size_t tstepA = 2 * hstepA, tstepB = 2 * hstepB;
    const unsigned ldsw = (unsigned)wid * 1024u;
    const int aoff = lds_byte(wr * 64 + fr, fq * 8), boff = lds_byte(wc * 32 + fr, fq * 8);
#define PG8_SA(b, h) (((b) * 2 + (h)) * HTB)
#define PG8_SB(b, h) ((4 + (b) * 2 + (h)) * HTB)
#define PG8_STAGE(bufoff, gbase, voff) do { _Pragma("unroll") for (int _i = 0; _i < 2; ++_i) \
        __builtin_amdgcn_global_load_lds((const unsigned*)((const char*)(gbase) + (voff)[_i]), (LAS unsigned*)(lds + (bufoff) + ldsw + _i * 8192), 16, 0, 0); } while (0)
#define PG8_LDA(dst, b, h) do { _Pragma("unroll") for (int m = 0; m < 4; ++m) _Pragma("unroll") for (int k = 0; k < 2; ++k) dst[m][k] = *(const LAS bf16x8*)(lds + PG8_SA(b, h) + aoff + m * 2048 + k * 1024); } while (0)
#define PG8_LDB(dst, b, h) do { _Pragma("unroll") for (int n = 0; n < 2; ++n) _Pragma("unroll") for (int k = 0; k < 2; ++k) dst[n][k] = *(const LAS bf16x8*)(lds + PG8_SB(b, h) + boff + n * 2048 + k * 1024); } while (0)
#define PG8_MMA(ai, bj, At, Bt) do { __builtin_amdgcn_s_setprio(1); _Pragma("unroll") for (int m = 0; m < 4; ++m) _Pragma("unroll") for (int n = 0; n < 2; ++n) _Pragma("unroll") for (int k = 0; k < 2; ++k) \
        acc[ai][bj][m][n] = __builtin_amdgcn_mfma_f32_16x16x32_bf16(Bt[n][k], At[m][k], acc[ai][bj][m][n], 0, 0, 0); __builtin_amdgcn_s_setprio(0); } while (0)
#define PG8_WAIT_V(n) asm volatile("s_waitcnt vmcnt(" #n ")" ::: "memory")
#define PG8_WAIT_L(n) asm volatile("s_waitcnt lgkmcnt(" #n ")" ::: "memory")
#define PG8_BAR __builtin_amdgcn_s_barrier()
#define PG8_SCHED __builtin_amdgcn_sched_barrier(0)
    Unit cur, nxt; int ui = 0;
    if (!S.next(0, cur)) return;
    f32x4 acc[2][2][4][2];
#pragma unroll
    for (int a = 0; a < 2; ++a)
#pragma unroll
        for (int b = 0; b < 2; ++b)
#pragma unroll
            for (int m = 0; m < 4; ++m)
#pragma unroll
                for (int n = 0; n < 2; ++n) acc[a][b][m][n] = (f32x4){0.f, 0.f, 0.f, 0.f};
    bf16x8 At[4][2], B0[2][2], B1[2][2];
    const char* cA = (const char*)g.A + (size_t)cur.pm * tstepA + (size_t)cur.pn * g.acoff * 2; const char* cB = (const char*)g.Bt + (size_t)cur.pn * tstepB;
    PG8_STAGE(PG8_SB(0, 0), cB, voffB); PG8_STAGE(PG8_SA(0, 0), cA, voffA); PG8_STAGE(PG8_SB(0, 1), cB + hstepB, voffB); PG8_STAGE(PG8_SA(0, 1), cA + hstepA, voffA);
    if (wr == 1) PG8_BAR;
    PG8_WAIT_V(4); PG8_BAR;
    PG8_STAGE(PG8_SB(1, 0), cB + kstep, voffB); PG8_STAGE(PG8_SA(1, 0), cA + kstep, voffA); PG8_STAGE(PG8_SB(1, 1), cB + hstepB + kstep, voffB);
    PG8_WAIT_V(6); PG8_BAR;
    for (;;) {
        const bool has_next = S.next(ui + 1, nxt);
        const char* nA = has_next ? (const char*)g.A + (size_t)nxt.pm * tstepA + (size_t)nxt.pn * g.acoff * 2 : cA; const char* nB = has_next ? (const char*)g.Bt + (size_t)nxt.pn * tstepB : cB;
#pragma unroll 1
        for (int t = 0; t < nt; t += 2) {
            const bool last = (t == nt - 2);
            const char* a1 = cA + (size_t)(t + 1) * kstep;
            const char* a2 = last ? nA : cA + (size_t)(t + 2) * kstep; const char* b2 = last ? nB : cB + (size_t)(t + 2) * kstep;
            const char* a3 = a2 + kstep; const char* b3 = b2 + kstep;
            PG8_LDB(B0, 0, 0); PG8_SCHED; PG8_LDA(At, 0, 0); PG8_STAGE(PG8_SA(1, 1), a1 + hstepA, voffA);
            PG8_WAIT_L(8); PG8_BAR; PG8_WAIT_L(0); PG8_MMA(0, 0, At, B0); PG8_BAR; PG8_SCHED;
            PG8_LDB(B1, 0, 1); PG8_STAGE(PG8_SB(0, 0), b2, voffB);
            PG8_BAR; PG8_WAIT_L(0); PG8_MMA(0, 1, At, B1); PG8_BAR;
            PG8_LDA(At, 0, 1); PG8_STAGE(PG8_SA(0, 0), a2, voffA);
            PG8_BAR; PG8_WAIT_L(0); PG8_MMA(1, 0, At, B0); PG8_BAR; PG8_SCHED;
            PG8_STAGE(PG8_SB(0, 1), b2 + hstepB, voffB);
            PG8_WAIT_V(6); PG8_BAR; PG8_MMA(1, 1, At, B1); PG8_BAR;
            PG8_LDB(B0, 1, 0); PG8_SCHED; PG8_LDA(At, 1, 0); PG8_STAGE(PG8_SA(0, 1), a2 + hstepA, voffA);
            PG8_WAIT_L(8); PG8_BAR; PG8_WAIT_L(0); PG8_MMA(0, 0, At, B0); PG8_BAR; PG8_SCHED;
            PG8_LDB(B1, 1, 1); PG8_STAGE(PG8_SB(1, 0), b3, voffB);
            PG8_BAR; PG8_WAIT_L(0); PG8_MMA(0, 1, At, B1); PG8_BAR;
            PG8_LDA(At, 1, 1); PG8_STAGE(PG8_SA(1, 0), a3, voffA);
            PG8_BAR; PG8_WAIT_L(0); PG8_MMA(1, 0, At, B0); PG8_BAR; PG8_SCHED;
            PG8_STAGE(PG8_SB(1, 1), b3 + hstepB, voffB);
            PG8_WAIT_V(6); PG8_BAR; PG8_MMA(1, 1, At, B1); PG8_BAR;
        }
        E(acc, cur, wr, wc, fr, fq);
        if (!has_next) break;
#pragma unroll
        for (int a = 0; a < 2; ++a)
#pragma unroll
            for (int b = 0; b < 2; ++b)
#pragma unroll
                for (int m = 0; m < 4; ++m)
#pragma unroll
                    for (int n = 0; n < 2; ++n) acc[a][b][m][n] = (f32x4){0.f, 0.f, 0.f, 0.f};
        cur = nxt; cA = nA; cB = nB; ++ui;
    }
    PG8_WAIT_V(0);
    if (wr == 0) PG8_BAR;
    PG8_BAR;
#undef PG8_SA
#undef PG8_SB
#undef PG8_STAGE
#undef PG8_LDA
#undef PG8_LDB
#undef PG8_MMA
#undef PG8_WAIT_V
#undef PG8_WAIT_L
#undef PG8_BAR
#undef PG8_SCHED
}
}
using pg8::Unit;
typedef f32x4 AccT[2][2][4][2];

struct EpiIn {
    static constexpr bool PERM = true;
    unsigned char* ws; float* out; int half;
    __device__ __forceinline__ void operator()(const AccT& acc, const Unit& u, int wr, int wc, int fr, int fq) const {
        const int pn = u.pn; const int row0 = u.pm * 256 + wr * 64 + fr;
        if (pn == 32) {
            if (wc == 0) { float* D = (float*)(ws + WS_DTR);
#pragma unroll
                for (int ai = 0; ai < 2; ++ai)
#pragma unroll
                    for (int m = 0; m < 4; ++m) { const int r = row0 + ai * 128 + m * 16;
                        *(f32x4*)(D + (size_t)r * 32 + 8 * fq) = acc[ai][0][m][0]; *(f32x4*)(D + (size_t)r * 32 + 8 * fq + 4) = acc[ai][0][m][1]; } }
            return; }
        bf16_t* base; int ld, radd = 0, c0; bool sig = false;
        if (pn < 4) { base = (bf16_t*)out; ld = 2048; radd = segoff(half, u.pm); c0 = pn * 256; }
        else if (pn < 12) { base = (bf16_t*)(ws + WS_Z); ld = 2048; c0 = (pn - 4) * 256; }
        else if (pn < 24) { base = (bf16_t*)(ws + WS_X); ld = 3072; c0 = (pn - 12) * 256; }
        else if (pn < 28) { base = (bf16_t*)out + 1024; ld = 2048; radd = segoff(half, u.pm); c0 = (pn - 24) * 256; sig = true; }
        else { base = (bf16_t*)(ws + WS_GB); ld = 1024; c0 = (pn - 28) * 256; sig = true; }
        const int col0 = c0 + wc * 32 + 8 * fq;
#pragma unroll
        for (int ai = 0; ai < 2; ++ai)
#pragma unroll
            for (int m = 0; m < 4; ++m) { bf16_t* rowp = base + (size_t)(row0 + radd + ai * 128 + m * 16) * ld + col0;
#pragma unroll
                for (int bj = 0; bj < 2; ++bj) { f32x4 v0 = acc[ai][bj][m][0], v1 = acc[ai][bj][m][1];
                    if (sig) {
#pragma unroll
                        for (int j = 0; j < 4; ++j) { v0[j] = sigmoidf_(v0[j]); v1[j] = sigmoidf_(v1[j]); } }
                    u32x4 w; w.x = cvt_pk_bf16(v0[0], v0[1]); w.y = cvt_pk_bf16(v0[2], v0[3]); w.z = cvt_pk_bf16(v1[0], v1[1]); w.w = cvt_pk_bf16(v1[2], v1[3]);
                    *(u32x4*)(rowp + bj * 128) = w; } }
    }
};
struct EpiPool {
    static constexpr bool PERM = true;
    bf16_t* O; const float* scale;
    __device__ __forceinline__ void operator()(const AccT& acc, const Unit& u, int wr, int wc, int fr, int fq) const {
        const int row0 = u.pm * 256 + wr * 64 + fr, col0 = u.pn * 256 + wc * 32 + 8 * fq;
        f32x4 sv[2][2];
#pragma unroll
        for (int bj = 0; bj < 2; ++bj)
#pragma unroll
            for (int n = 0; n < 2; ++n) sv[bj][n] = *(const f32x4*)(scale + col0 + bj * 128 + 4 * n);
#pragma unroll
        for (int ai = 0; ai < 2; ++ai)
#pragma unroll
            for (int m = 0; m < 4; ++m) { bf16_t* rowp = O + (size_t)(row0 + ai * 128 + m * 16) * 1024 + col0;
#pragma unroll
                for (int bj = 0; bj < 2; ++bj) { f32x4 v0 = acc[ai][bj][m][0] * sv[bj][0], v1 = acc[ai][bj][m][1] * sv[bj][1];
                    u32x4 w; w.x = cvt_pk_bf16(v0[0], v0[1]); w.y = cvt_pk_bf16(v0[2], v0[3]); w.z = cvt_pk_bf16(v1[0], v1[1]); w.w = cvt_pk_bf16(v1[2], v1[3]);
                    *(u32x4*)(rowp + bj * 128) = w; } }
    }
};
struct EpiA {
    static constexpr bool PERM = true;
    bf16_t* O; const bf16_t* GA  ; int half;
    __device__ __forceinline__ void operator()(const AccT& acc, const Unit& u, int wr, int wc, int fr, int fq) const {
        const int row0 = u.pm * 256 + wr * 64 + fr, col0 = u.pn * 256 + wc * 32 + 8 * fq, radd = segoff(half, u.pm);
#pragma unroll
        for (int ai = 0; ai < 2; ++ai)
#pragma unroll
            for (int m = 0; m < 4; ++m) { const int r = row0 + ai * 128 + m * 16; bf16_t* rowp = O + (size_t)r * 1024 + col0; const bf16_t* gp = GA + (size_t)(r + radd) * 2048 + col0;
#pragma unroll
                for (int bj = 0; bj < 2; ++bj) { const u32x4 gv = *(const u32x4*)(gp + bj * 128); const f32x4 v0 = acc[ai][bj][m][0], v1 = acc[ai][bj][m][1];
                    u32x4 w; w.x = cvt_pk_bf16(v0[0] * bflo(gv.x), v0[1] * bfhi(gv.x)); w.y = cvt_pk_bf16(v0[2] * bflo(gv.y), v0[3] * bfhi(gv.y));
                    w.z = cvt_pk_bf16(v1[0] * bflo(gv.z), v1[1] * bfhi(gv.z)); w.w = cvt_pk_bf16(v1[2] * bflo(gv.w), v1[3] * bfhi(gv.w));
                    *(u32x4*)(rowp + bj * 128) = w; } }
    }
};
struct EpiB {
    static constexpr bool PERM = true;
    bf16_t* GBM; const bf16_t* MA;
    __device__ __forceinline__ void operator()(const AccT& acc, const Unit& u, int wr, int wc, int fr, int fq) const {
        const int row0 = u.pm * 256 + wr * 64 + fr, col0 = u.pn * 256 + wc * 32 + 8 * fq;
#pragma unroll
        for (int ai = 0; ai < 2; ++ai)
#pragma unroll
            for (int m = 0; m < 4; ++m) { const size_t ro = (size_t)(row0 + ai * 128 + m * 16) * 1024 + col0;
#pragma unroll
                for (int bj = 0; bj < 2; ++bj) { const u32x4 gv = *(const u32x4*)(GBM + ro + bj * 128); const u32x4 av = *(const u32x4*)(MA + ro + bj * 128); const f32x4 v0 = acc[ai][bj][m][0], v1 = acc[ai][bj][m][1];
                    u32x4 w; w.x = cvt_pk_bf16(bflo(av.x) + v0[0] * bflo(gv.x), bfhi(av.x) + v0[1] * bfhi(gv.x)); w.y = cvt_pk_bf16(bflo(av.y) + v0[2] * bflo(gv.y), bfhi(av.y) + v0[3] * bfhi(gv.y));
                    w.z = cvt_pk_bf16(bflo(av.z) + v1[0] * bflo(gv.z), bfhi(av.z) + v1[1] * bfhi(gv.z)); w.w = cvt_pk_bf16(bflo(av.w) + v1[2] * bflo(gv.w), bfhi(av.w) + v1[3] * bfhi(gv.w));
                    *(u32x4*)(GBM + ro + bj * 128) = w; } }
    }
};
struct EpiRes {
    static constexpr bool PERM = false;
    float* dst; const float* xp; const float* xs; const float* mod; int goff; int half; int inplace;
    __device__ __forceinline__ void operator()(const AccT& acc, const Unit& u, int wr, int wc, int fr, int fq) const {
        const int row0 = u.pm * 256 + wr * 64 + fr, col0 = u.pn * 256 + wc * 32 + 4 * fq;
#pragma unroll
        for (int ai = 0; ai < 2; ++ai)
#pragma unroll
            for (int m = 0; m < 4; ++m) { const int r = row0 + ai * 128 + m * 16; const int gt = gtok(half, r);
                float* dp = dst + (size_t)gt * 1024 + col0;
                const float* sp = inplace ? dp : (r < 8192 ? xp + (size_t)(half * 8192 + r) * 1024 + col0 : xs + (size_t)(half * 1024 + r - 8192) * 1024 + col0);
                const float* gp = mod + (size_t)modrow(half, r) * 6144 + goff + col0;
#pragma unroll
                for (int bj = 0; bj < 2; ++bj)
#pragma unroll
                    for (int n = 0; n < 2; ++n) { const int o = bj * 128 + n * 16; const f32x4 s = *(const f32x4*)(sp + o), gg = *(const f32x4*)(gp + o);
                        *(f32x4*)(dp + o) = s + gg * acc[ai][bj][m][n]; } }
    }
};
struct EpiF1 {
    static constexpr bool PERM = false;
    bf16_t* O;
    __device__ __forceinline__ void operator()(const AccT& acc, const Unit& u, int wr, int wc, int fr, int fq) const {
        const int row0 = u.pm * 256 + wr * 64 + fr, col0 = u.pn * 128 + wc * 16 + 4 * fq;
#pragma unroll
        for (int ai = 0; ai < 2; ++ai)
#pragma unroll
            for (int m = 0; m < 4; ++m) { bf16_t* rowp = O + (size_t)(row0 + ai * 128 + m * 16) * DFF + col0;
#pragma unroll
                for (int bj = 0; bj < 2; ++bj) { const f32x4 a = acc[ai][bj][m][0], b = acc[ai][bj][m][1];
                    u32x2 w; w.x = cvt_pk_bf16(siluf_(a[0]) * b[0], siluf_(a[1]) * b[1]); w.y = cvt_pk_bf16(siluf_(a[2]) * b[2], siluf_(a[3]) * b[3]);
                    *(u32x2*)(rowp + bj * 64) = w; } }
    }
};

__device__ __forceinline__ const float* wsrc(const Params& p, int w, int r, int& ld) {
    switch (w) {
    case 0: { ld = NIN; const float* b = p.in[11]; if (r < 6144) return b + r; if (r < 8192) return b + r + 32; if (r < 8224) return b + 6144 + (r - 8192); return nullptr; }
    case 1: ld = 256; return p.in[12] + (size_t)(r >> 8) * 65536 + (r & 255);
    case 2: ld = 1024; return p.in[20] + r;
    case 3: ld = 1024; return p.in[21] + r;
    case 4: ld = 1024; return p.in[22] + r;
    case 5: { ld = DFF; const int pn = r >> 8, bj = (r >> 7) & 1, wc = (r >> 5) & 3, n = (r >> 4) & 1, fq = (r >> 2) & 3, e = r & 3; const int G = pn * 128 + bj * 64 + wc * 16 + fq * 4 + e; return (n ? p.in[24] : p.in[23]) + G; }
    default: ld = 1024; return p.in[25] + r;
    }
}
constexpr int P0_EARLY = 608, P0_ALL = 1328;
__device__ __forceinline__ void p0_tiles(const Params& p, float* lds, int tile_lo, int tile_hi, int first, int stride) {
    const int t = otid();
#pragma unroll 1
    for (int item = 96 + tile_lo + first; item < 96 + tile_hi; item += stride) {
            int ti = item - 96, w, ktw; size_t wow;
            if (ti < 528) { w = 0; ktw = 16; wow = WS_WIN; }
            else if ((ti -= 528) < 16) { w = 1; ktw = 4; wow = WS_WGRP; }
            else if ((ti -= 16) < 64) { w = 2; ktw = 16; wow = WS_WA; }
            else if ((ti -= 64) < 128) { w = 3; ktw = 32; wow = WS_WB; }
            else if ((ti -= 128) < 64) { w = 4; ktw = 16; wow = WS_WOUT; }
            else if ((ti -= 64) < 352) { w = 5; ktw = 16; wow = WS_WF1; }
            else { ti -= 352; w = 6; ktw = 44; wow = WS_WF2; }
            const int K = ktw * 64, r0 = (ti / ktw) * 256, k0 = (ti % ktw) * 64;
            { const int rq = t & 63, kq = t >> 6; int ld; const float* sp = wsrc(p, w, r0 + 4 * rq, ld);
                f32x4 v[8];
#pragma unroll
                for (int i = 0; i < 8; ++i) v[i] = sp ? *(const f32x4*)(sp + (size_t)(k0 + kq + 8 * i) * ld) : (f32x4){0.f, 0.f, 0.f, 0.f};
#pragma unroll
                for (int i = 0; i < 8; ++i) { const int kl = kq + 8 * i; *(f32x4*)(lds + kl * 260 + (kl >> 3) * 4 + 4 * rq) = v[i]; } }
            __syncthreads();
#pragma unroll
            for (int i = 0; i < 4; ++i) { const int task = t + 512 * i, kc = task & 7, n = task >> 3; float v[8];
#pragma unroll
                for (int j = 0; j < 8; ++j) v[j] = lds[(kc * 8 + j) * 260 + kc * 4 + n];
                u32x4 o; o.x = cvt_pk_bf16(v[0], v[1]); o.y = cvt_pk_bf16(v[2], v[3]); o.z = cvt_pk_bf16(v[4], v[5]); o.w = cvt_pk_bf16(v[6], v[7]);
                *(u32x4*)((bf16_t*)(p.ws + wow) + (size_t)(r0 + n) * K + k0 + kc * 8) = o; }
            __syncthreads();
    }
}
__device__ __forceinline__ void p0_mod(const Params& p, float* lds, int first, int stride) {
    const int t = otid();
#pragma unroll 1
    for (int item = first; item < 96; item += stride) {
            const int slab = item, jc = t & 63, kg = t >> 6;
            float acc[34];
#pragma unroll
            for (int b = 0; b < 34; ++b) acc[b] = 0.f;
            for (int kh = 0; kh < 2; ++kh) {
                __syncthreads();
                { float cv[34];
#pragma unroll
                    for (int b = 0; b < 34; ++b) cv[b] = (b < 2 ? p.in[2] + b * 1024 : p.in[3] + (b - 2) * 1024)[kh * 512 + t];
#pragma unroll
                    for (int b = 0; b < 34; ++b) lds[b * 512 + t] = siluf_(cv[b]); }
                __syncthreads();
                const float* wp = p.in[7] + (size_t)(kh * 512 + kg * 64) * 6144 + slab * 64 + jc;
#pragma unroll 1
                for (int k8 = 0; k8 < 64; k8 += 16) { float wv[16];
#pragma unroll
                    for (int j = 0; j < 16; ++j) wv[j] = wp[(size_t)(k8 + j) * 6144];
#pragma unroll
                    for (int j = 0; j < 16; ++j)
#pragma unroll
                        for (int b = 0; b < 34; ++b) acc[b] += lds[b * 512 + kg * 64 + k8 + j] * wv[j]; }
            }
            __syncthreads();
#pragma unroll
            for (int b = 0; b < 34; ++b) lds[(kg * 34 + b) * 64 + jc] = acc[b];
            __syncthreads();
            for (int o = t; o < 34 * 64; o += 512) { const int b = o >> 6, j = o & 63; float sacc = 0.f;
#pragma unroll
                for (int k8 = 0; k8 < 8; ++k8) sacc += lds[(k8 * 34 + b) * 64 + j];
                ((float*)(p.ws + WS_MOD))[b * 6144 + slab * 64 + j] = sacc + p.in[8][slab * 64 + j]; }
            __syncthreads();
    }
}

template <int MODE>
__device__ __forceinline__ void norm_phase(const Params& p, int half) {
    const int t_ = otid(), bid = obid(); const int lane = t_ & 63, wv = t_ >> 6;
    const float* w = MODE == 0 ? p.in[9] : (MODE == 1 ? p.in[10] : p.in[26]);
    f32x4 wq[4];
#pragma unroll
    for (int i = 0; i < 4; ++i) wq[i] = *(const f32x4*)(w + i * 256 + lane * 4);
    for (int r = bid * 8 + wv; r < HR; r += gridDim.x * 8) {
        const float* src;
        if (MODE == 0) src = r < 8192 ? p.in[0] + (size_t)(half * 8192 + r) * 1024 : p.in[1] + (size_t)(half * 1024 + r - 8192) * 1024;
        else src = p.out + (size_t)gtok(half, r) * 1024;
        f32x4 v[4]; float ss = 0.f;
#pragma unroll
        for (int i = 0; i < 4; ++i) { v[i] = *(const f32x4*)(src + i * 256 + lane * 4); ss += v[i][0] * v[i][0] + v[i][1] * v[i][1] + v[i][2] * v[i][2] + v[i][3] * v[i][3]; }
        ss = wave_sum(ss);
        const float rstd = rsqrtf(ss * (1.0f / 1024.0f) + 1e-6f);
        if (MODE == 2) {
            float* dst = p.out + (size_t)gtok(half, r) * 1024;
#pragma unroll
            for (int i = 0; i < 4; ++i) *(f32x4*)(dst + i * 256 + lane * 4) = v[i] * rstd * wq[i];
        } else {
            const float* mr = (const float*)(p.ws + WS_MOD) + (size_t)modrow(half, r) * 6144 + (MODE == 0 ? 0 : 3072);
            bf16_t* dst = (bf16_t*)(p.ws + WS_H) + (size_t)r * 1024;
#pragma unroll
            for (int i = 0; i < 4; ++i) { const f32x4 sh = *(const f32x4*)(mr + i * 256 + lane * 4), sc = *(const f32x4*)(mr + 1024 + i * 256 + lane * 4);
                const f32x4 y = (v[i] * rstd * wq[i]) * (sc + 1.0f) + sh;
                u32x2 o; o.x = cvt_pk_bf16(y[0], y[1]); o.y = cvt_pk_bf16(y[2], y[3]); *(u32x2*)(dst + i * 256 + lane * 4) = o; }
        }
    }
}

template <int W>
__device__ __forceinline__ void pool_pass(const Params& p, int half, int lc, int grp, int lg, int lane) {
    const int ch = grp * 256 + lane * 4, l0 = lg * 8;
    const bool sample = lc >= 128, first = sample || lc == 0;
    const int sb = 16 * half + lc - 128;
    const int r0 = lc * 64, radd = sample ? 8192 + half * 1024 : half * 8192;
    const bf16_t* Pb = (const bf16_t*)p.out + (size_t)(r0 + l0 + radd) * 2048 + ch;
    float v[23][4];
#pragma unroll
    for (int i = 0; i < 23; ++i) { const int l = l0 - 15 + i;
        if (l >= 0 || !first) { const u32x2 w = *(const u32x2*)(Pb + (ptrdiff_t)(i - 15) * 2048); v[i][0] = bflo(w.x); v[i][1] = bfhi(w.x); v[i][2] = bflo(w.y); v[i][3] = bfhi(w.y); }
        else if (sample) { const f32x4 f = *(const f32x4*)(p.in[4] + ((size_t)sb * 15 + 15 + l) * 1024 + ch); v[i][0] = f[0]; v[i][1] = f[1]; v[i][2] = f[2]; v[i][3] = f[3]; }
        else { v[i][0] = v[i][1] = v[i][2] = v[i][3] = 0.f; } }
    float S[4] = {0.f, 0.f, 0.f, 0.f};
#pragma unroll
    for (int j = 0; j < W; ++j)
#pragma unroll
        for (int c = 0; c < 4; ++c) S[c] += v[15 - j][c];
    bf16_t* M = (bf16_t*)(p.ws + WS_H);
#pragma unroll
    for (int i = 0; i < 8; ++i) {
        if (i > 0) {
#pragma unroll
            for (int c = 0; c < 4; ++c) S[c] += v[15 + i][c] - v[15 + i - W][c]; }
        const int l = l0 + i; const int pos1 = sample ? 4097 + l : r0 + l + 1;
        const float rc = 1.0f / (float)(pos1 < W ? pos1 : W);
        u32x2 o; o.x = cvt_pk_bf16(S[0] * rc - v[15 + i][0], S[1] * rc - v[15 + i][1]); o.y = cvt_pk_bf16(S[2] * rc - v[15 + i][2], S[3] * rc - v[15 + i][3]);
        *(u32x2*)(M + (size_t)(r0 + l) * 1024 + ch) = o;
        if ((sample || lc == 127) && l >= 49) {
            float* op = sample ? p.out + O_POOLS + ((size_t)sb * 15 + (l - 49)) * 1024 + ch : p.out + O_POOLP + ((size_t)half * 15 + (l - 49)) * 1024 + ch;
            *(f32x4*)op = (f32x4){v[15 + i][0], v[15 + i][1], v[15 + i][2], v[15 + i][3]}; }
    }
}
__device__ __forceinline__ void s1_phase(const Params& p, int half, float* lds) {
    const int t0_ = otid(), bid = obid(); const int wid = __builtin_amdgcn_readfirstlane(t0_ >> 6);
    for (int item = bid; item < NCHK * 11; item += gridDim.x) {
        int t = t0_; asm volatile("" : "+v"(t)); const int lane = t & 63;
        const int lc = item / 11, sub = item % 11;
        const bool sample = lc >= 128, first = sample || lc == 0;
        const int sb = 16 * half + lc - 128;
        const int r0 = lc * 64;
        if (sub < 6) {
            const int lg = wid, l0 = lg * 8, col = sub * 512 + lane * 8;
            const bf16_t* Xb = (const bf16_t*)(p.ws + WS_X) + (size_t)(r0 + l0) * 3072 + col;
            float v[11][8];
#pragma unroll
            for (int i = 0; i < 11; ++i) { const int l = l0 - 3 + i;
                if (l >= 0 || !first) { const u32x4 w = *(const u32x4*)(Xb + (ptrdiff_t)(i - 3) * 3072);
                    v[i][0] = bflo(w.x); v[i][1] = bfhi(w.x); v[i][2] = bflo(w.y); v[i][3] = bfhi(w.y); v[i][4] = bflo(w.z); v[i][5] = bfhi(w.z); v[i][6] = bflo(w.w); v[i][7] = bfhi(w.w); }
                else if (sample) { const float* hp = p.in[5] + ((size_t)sb * 3 + 3 + l) * 3072 + col; const f32x4 f0 = *(const f32x4*)hp, f1 = *(const f32x4*)(hp + 4);
#pragma unroll
                    for (int c = 0; c < 4; ++c) { v[i][c] = f0[c]; v[i][4 + c] = f1[c]; } }
                else {
#pragma unroll
                    for (int c = 0; c < 8; ++c) v[i][c] = 0.f; } }
            if ((sample || lc == 127) && lg == 7) {
                float* o3 = sample ? p.out + O_CONVS + (size_t)sb * 3 * 3072 + col : p.out + O_CONVP + (size_t)half * 3 * 3072 + col;
#pragma unroll
                for (int k = 0; k < 3; ++k) { *(f32x4*)(o3 + (size_t)k * 3072) = (f32x4){v[8 + k][0], v[8 + k][1], v[8 + k][2], v[8 + k][3]}; *(f32x4*)(o3 + (size_t)k * 3072 + 4) = (f32x4){v[8 + k][4], v[8 + k][5], v[8 + k][6], v[8 + k][7]}; } }
            float wk[4][8], cbv[8];
#pragma unroll
            for (int k = 0; k < 4; ++k) { const f32x4 a0 = *(const f32x4*)(p.in[14] + (size_t)k * 3072 + col), a1 = *(const f32x4*)(p.in[14] + (size_t)k * 3072 + col + 4);
#pragma unroll
                for (int c = 0; c < 4; ++c) { wk[k][c] = a0[c]; wk[k][4 + c] = a1[c]; } }
            { const f32x4 a0 = *(const f32x4*)(p.in[15] + col), a1 = *(const f32x4*)(p.in[15] + col + 4);
#pragma unroll
                for (int c = 0; c < 4; ++c) { cbv[c] = a0[c]; cbv[4 + c] = a1[c]; } }
#pragma unroll
            for (int li = 0; li < 8; ++li)
#pragma unroll
                for (int c = 0; c < 8; ++c) v[li][c] = siluf_(cbv[c] + wk[0][c] * v[li][c] + wk[1][c] * v[li + 1][c] + wk[2][c] * v[li + 2][c] + wk[3][c] * v[li + 3][c]);
            if (sub >= 4) {
                const int ncol = col - (sub == 4 ? 2048 : 2560), g = ncol >> 7, n = ncol & 127;
                bf16_t* RM = (bf16_t*)(p.ws + (sub == 4 ? WS_BM : WS_CM)) + ((size_t)(lc * 4 + g) * 64 + l0) * 128 + n;
#pragma unroll
                for (int li = 0; li < 8; ++li) { u32x4 o; o.x = cvt_pk_bf16(v[li][0], v[li][1]); o.y = cvt_pk_bf16(v[li][2], v[li][3]); o.z = cvt_pk_bf16(v[li][4], v[li][5]); o.w = cvt_pk_bf16(v[li][6], v[li][7]);
                    *(u32x4*)(RM + (size_t)li * 128) = o; } }
            if (sub <= 4) {
                bf16_t* TB;
                if (sub < 4) { const int head = col >> 6, pp = col & 63; TB = (bf16_t*)(p.ws + WS_XT) + (((size_t)lc * 32 + head) * 64 + pp) * 64 + l0; }
                else { const int ncol = col - 2048, g = ncol >> 7, n = ncol & 127; TB = (bf16_t*)(p.ws + WS_BT) + ((size_t)(lc * 4 + g) * 128 + n) * 64 + l0; }
#pragma unroll
                for (int c = 0; c < 8; ++c) { u32x4 o; o.x = cvt_pk_bf16(v[0][c], v[1][c]); o.y = cvt_pk_bf16(v[2][c], v[3][c]); o.z = cvt_pk_bf16(v[4][c], v[5][c]); o.w = cvt_pk_bf16(v[6][c], v[7][c]);
                    *(u32x4*)(TB + (size_t)c * 64) = o; } }
        } else if (sub < 10) {
            const int grp = sub - 6;
            if (grp == 0) pool_pass<2>(p, half, lc, grp, wid, lane); else if (grp == 1) pool_pass<4>(p, half, lc, grp, wid, lane); else if (grp == 2) pool_pass<8>(p, half, lc, grp, wid, lane); else pool_pass<16>(p, half, lc, grp, wid, lane);
        } else {
            const int h = t & 31, lq = t >> 5;
            const float bias = p.in[16][h], A = -__expf(p.in[17][h]);
            const float* D = (const float*)(p.ws + WS_DTR);
            float dt[4], cs[4]; float run = 0.f;
#pragma unroll
            for (int j = 0; j < 4; ++j) { const float x = D[(size_t)(r0 + lq * 4 + j) * 32 + h] + bias; dt[j] = fmaxf(x, 0.f) + log1pf(__expf(-fabsf(x))); run += dt[j] * A; cs[j] = run; }
            __syncthreads();
            lds[lq * 32 + h] = run;
            __syncthreads();
            float base = 0.f;
            for (int k = 0; k < lq; ++k) base += lds[k * 32 + h];
            float* DT = (float*)(p.ws + WS_DTC) + ((size_t)lc * 32 + h) * 64 + lq * 4; float* AC = (float*)(p.ws + WS_ACS) + ((size_t)lc * 32 + h) * 64 + lq * 4;
            *(f32x4*)DT = (f32x4){dt[0], dt[1], dt[2], dt[3]}; *(f32x4*)AC = (f32x4){base + cs[0], base + cs[1], base + cs[2], base + cs[3]};
        }
    }
}

__device__ __forceinline__ bf16x8 pack8(const float* v) { u32x4 w; w.x = cvt_pk_bf16(v[0], v[1]); w.y = cvt_pk_bf16(v[2], v[3]); w.z = cvt_pk_bf16(v[4], v[5]); w.w = cvt_pk_bf16(v[6], v[7]); return __builtin_bit_cast(bf16x8, w); }
constexpr int SL_CM = 0, SL_CB = 64 * 272, SL_BT = SL_CB + 64 * 144, SL_AD = SL_BT + 128 * 144, SL_SIZE = SL_AD + 1024;
struct StageRegs { u32x4 r[5]; u32x4 ad; };
template <bool FULL>
__device__ __forceinline__ void stage_load(StageRegs& R, const unsigned char* ws, int lc, int g, int h0, int t) {
    if (FULL) {
        const u32x4* cm = (const u32x4*)(ws + WS_CM + (size_t)(lc * 4 + g) * 16384); R.r[0] = cm[t]; R.r[1] = cm[t + 512];
        R.r[2] = ((const u32x4*)(ws + WS_CB + (size_t)(lc * 4 + g) * 8192))[t]; }
    const u32x4* bt = (const u32x4*)(ws + WS_BT + (size_t)(lc * 4 + g) * 16384); R.r[3] = bt[t]; R.r[4] = bt[t + 512];
    if (t < 64) { const int e = t >> 5, part = (t >> 4) & 1, c = t & 15; R.ad = *(const u32x4*)(ws + (part ? WS_DTC : WS_ACS) + ((size_t)(lc * 32 + h0 + e) * 64) * 4 + c * 16); }
}
template <bool FULL>
__device__ __forceinline__ void stage_store(const StageRegs& R, LAS unsigned char* B, int t) {
    if (FULL) {
        *(LAS u32x4*)(B + SL_CM + (t >> 4) * 272 + (t & 15) * 16) = R.r[0]; *(LAS u32x4*)(B + SL_CM + (32 + (t >> 4)) * 272 + (t & 15) * 16) = R.r[1];
        *(LAS u32x4*)(B + SL_CB + (t >> 3) * 144 + (t & 7) * 16) = R.r[2]; }
    *(LAS u32x4*)(B + SL_BT + (t >> 3) * 144 + (t & 7) * 16) = R.r[3]; *(LAS u32x4*)(B + SL_BT + (64 + (t >> 3)) * 144 + (t & 7) * 16) = R.r[4];
    if (t < 64) *(LAS u32x4*)(B + SL_AD + t * 16) = R.ad;
}
struct XtRegs { bf16x8 xf[2]; bf16x4 xd[4]; };
template <bool FULL>
__device__ __forceinline__ void xt_load(XtRegs& X, const unsigned char* ws, int lc, int h, int pw, int c16, int q) {
    const bf16_t* XTp = (const bf16_t*)(ws + WS_XT) + (((size_t)lc * 32 + h) * 64 + pw + c16) * 64;
    X.xf[0] = *(const bf16x8*)(XTp + 8 * q); X.xf[1] = *(const bf16x8*)(XTp + 32 + 8 * q);
    if (FULL) {
#pragma unroll
        for (int lt = 0; lt < 4; ++lt) X.xd[lt] = *(const bf16x4*)(XTp + 16 * lt + 4 * q); }
}
template <bool FULL>
__device__ __forceinline__ void ssd_step(f32x4 (&H)[8], LAS unsigned char* B, int hsel, const XtRegs& X, unsigned char* ws, int lc, int h, int pw, int c16, int q, float dskip) {
    LAS unsigned char* AD = B + SL_AD + hsel * 512;
    float acs_k[16], dt_k[16];
#pragma unroll
    for (int kk = 0; kk < 2; ++kk) { const f32x4 a0 = *(LAS f32x4*)(AD + (32 * kk + 8 * q) * 4), a1 = *(LAS f32x4*)(AD + (32 * kk + 8 * q + 4) * 4), d0 = *(LAS f32x4*)(AD + 256 + (32 * kk + 8 * q) * 4), d1 = *(LAS f32x4*)(AD + 256 + (32 * kk + 8 * q + 4) * 4);
#pragma unroll
        for (int j = 0; j < 4; ++j) { acs_k[kk * 8 + j] = a0[j]; acs_k[kk * 8 + 4 + j] = a1[j]; dt_k[kk * 8 + j] = d0[j]; dt_k[kk * 8 + 4 + j] = d1[j]; } }
    const float acs63 = *(LAS float*)(AD + 63 * 4);
    if (FULL) {
        bf16_t* Y = (bf16_t*)(ws + WS_X);
        bf16x8 hf[4];
#pragma unroll
        for (int kk = 0; kk < 4; ++kk) { float tv[8];
#pragma unroll
            for (int j = 0; j < 4; ++j) { tv[j] = H[2 * kk][j]; tv[4 + j] = H[2 * kk + 1][j]; }
            hf[kk] = pack8(tv); }
#pragma unroll
        for (int lt = 0; lt < 4; ++lt) {
            const int l = 16 * lt + c16;
            bf16x8 cf[4], cb[2];
#pragma unroll
            for (int kk = 0; kk < 4; ++kk) cf[kk] = *(LAS bf16x8*)(B + SL_CM + l * 272 + (32 * kk + 8 * q) * 2);
#pragma unroll
            for (int kk = 0; kk < 2; ++kk) if (kk <= (lt >> 1)) cb[kk] = *(LAS bf16x8*)(B + SL_CB + l * 144 + (32 * kk + 8 * q) * 2);
            const f32x4 ad = *(LAS f32x4*)(AD + (16 * lt + 4 * q) * 4);
            const float arow = *(LAS float*)(AD + l * 4);
            f32x4 y = {0.f, 0.f, 0.f, 0.f};
#pragma unroll
            for (int kk = 0; kk < 4; ++kk) y = __builtin_amdgcn_mfma_f32_16x16x32_bf16(cf[kk], hf[kk], y, 0, 0, 0);
#pragma unroll
            for (int i = 0; i < 4; ++i) y[i] *= __expf(ad[i]);
#pragma unroll
            for (int kk = 0; kk < 2; ++kk) if (kk <= (lt >> 1)) { float lm[8];
#pragma unroll
                for (int j = 0; j < 8; ++j) { const int s_ = 32 * kk + 8 * q + j; lm[j] = (s_ <= l) ? bf2f(cb[kk][j]) * __expf(arow - acs_k[kk * 8 + j]) * dt_k[kk * 8 + j] : 0.f; }
                y = __builtin_amdgcn_mfma_f32_16x16x32_bf16(pack8(lm), X.xf[kk], y, 0, 0, 0); }
#pragma unroll
            for (int i = 0; i < 4; ++i) { const float yv = y[i] + dskip * bf2f(X.xd[lt][i]);
                Y[(size_t)(lc * 64 + 16 * lt + 4 * q + i) * 2048 + h * 64 + pw + c16] = (bf16_t)(cvt_pk_bf16(yv, 0.f) & 0xffffu); }
        }
    }
    const float dec = __expf(acs63);
    bf16x8 xw[2];
#pragma unroll
    for (int kk = 0; kk < 2; ++kk) { float tv[8];
#pragma unroll
        for (int j = 0; j < 8; ++j) tv[j] = bf2f(X.xf[kk][j]) * dt_k[kk * 8 + j] * __expf(acs63 - acs_k[kk * 8 + j]);
        xw[kk] = pack8(tv); }
    const int nlane = 8 * (c16 >> 2) + (c16 & 3);
#pragma unroll
    for (int np = 0; np < 4; ++np) {
        bf16x8 bt[2][2];
#pragma unroll
        for (int e = 0; e < 2; ++e)
#pragma unroll
            for (int kk = 0; kk < 2; ++kk) bt[e][kk] = *(LAS bf16x8*)(B + SL_BT + (32 * np + nlane + 4 * e) * 144 + (32 * kk + 8 * q) * 2);
#pragma unroll
        for (int e = 0; e < 2; ++e) { H[2 * np + e] *= dec;
#pragma unroll
            for (int kk = 0; kk < 2; ++kk) H[2 * np + e] = __builtin_amdgcn_mfma_f32_16x16x32_bf16(bt[e][kk], xw[kk], H[2 * np + e], 0, 0, 0); } }
}
template <bool FULL>
__device__ __forceinline__ void ssd_walk(f32x4 (&H)[8], LAS unsigned char* lds, unsigned char* ws, int lc0, int nsteps, int h0, int t, int quad, int pw, int c16, int q, float dskip) {
    const int g = h0 >> 3, h = h0 + quad;
    StageRegs R; XtRegs Xn, X;
    stage_load<FULL>(R, ws, lc0, g, h0, t); xt_load<FULL>(Xn, ws, lc0, h, pw, c16, q);
    stage_store<FULL>(R, lds, t);
    __syncthreads();
#pragma unroll 1
    for (int c = 0; c < nsteps; ++c) {
        X = Xn;
        const bool more = c + 1 < nsteps;
        if (more) { stage_load<FULL>(R, ws, lc0 + c + 1, g, h0, t); xt_load<FULL>(Xn, ws, lc0 + c + 1, h, pw, c16, q); }
        ssd_step<FULL>(H, lds + (c & 1) * SL_SIZE, quad, X, ws, lc0 + c, h, pw, c16, q, dskip);
        if (more) stage_store<FULL>(R, lds + ((c + 1) & 1) * SL_SIZE, t);
        __syncthreads();
    }
}
__device__ __forceinline__ int n0_of(int nt, int q) { return 32 * (nt >> 1) + 8 * q + 4 * (nt & 1); }
__device__ __forceinline__ void cb_item(const unsigned char* ws, int idx, int w4, int c16, int q) {
    const bf16_t* Bp = (const bf16_t*)(ws + WS_BM) + (size_t)idx * 64 * 128; const bf16_t* Cp = (const bf16_t*)(ws + WS_CM) + (size_t)idx * 64 * 128;
    bf16_t* O = (bf16_t*)(ws + WS_CB) + (size_t)idx * 64 * 64;
    const int lt = w4;
    bf16x8 cf[4];
#pragma unroll
    for (int kk = 0; kk < 4; ++kk) cf[kk] = *(const bf16x8*)(Cp + (size_t)(16 * lt + c16) * 128 + 32 * kk + 8 * q);
    for (int st = 0; st <= lt; ++st) { f32x4 d = {0.f, 0.f, 0.f, 0.f};
#pragma unroll
        for (int kk = 0; kk < 4; ++kk) { const bf16x8 bfr = *(const bf16x8*)(Bp + (size_t)(16 * st + c16) * 128 + 32 * kk + 8 * q); d = __builtin_amdgcn_mfma_f32_16x16x32_bf16(bfr, cf[kk], d, 0, 0, 0); }
        u32x2 o; o.x = cvt_pk_bf16(d[0], d[1]); o.y = cvt_pk_bf16(d[2], d[3]);
        *(u32x2*)(O + (size_t)(16 * lt + c16) * 64 + 16 * st + 4 * q) = o; }
}
__device__ __forceinline__ void mix1_quads(const Params& p, int half, LAS unsigned char* lds) {
    const int t = otid(), bid = obid(); const int wid = __builtin_amdgcn_readfirstlane(t >> 6), lane = t & 63, quad = wid >> 2, w4 = wid & 3, c16 = lane & 15, q = lane >> 4, pw = w4 * 16;
    for (int item = bid; item < 240; item += gridDim.x) { const int k = item >> 4, h0 = (item & 15) * 2;
        f32x4 H[8];
#pragma unroll
        for (int nt = 0; nt < 8; ++nt) H[nt] = (f32x4){0.f, 0.f, 0.f, 0.f};
        ssd_walk<false>(H, lds, p.ws, 8 * k, 8, h0, t, quad, pw, c16, q, 0.f);
        float* ST = (float*)(p.ws + WS_ST) + (((size_t)k * 32 + h0 + quad) * 64 + pw + c16) * 128;
#pragma unroll
        for (int nt = 0; nt < 8; ++nt) *(f32x4*)(ST + n0_of(nt, q)) = H[nt];
    }
    for (int item = (gridDim.x - 1 - bid) * 2 + quad; item < NCHK * 4; item += gridDim.x * 2) cb_item(p.ws, item, w4, c16, q);
}
__device__ __forceinline__ void passb(const Params& p) {
    const int vb = gridDim.x - 1 - obid(); const int t_ = otid();
    for (int v = vb * 512 + t_; v < 65536; v += gridDim.x * 512) {
        const int h = v >> 11; f32x4 carry = {0.f, 0.f, 0.f, 0.f};
        float* ST = (float*)(p.ws + WS_ST) + (size_t)v * 4; const float* AC = (const float*)(p.ws + WS_ACS);
        for (int k = 0; k < 15; ++k) { float a = 0.f;
#pragma unroll
            for (int c = 0; c < 8; ++c) a += AC[((size_t)(8 * k + c) * 32 + h) * 64 + 63];
            const f32x4 s = *(const f32x4*)(ST + (size_t)k * 262144); carry = carry * __expf(a) + s; *(f32x4*)(ST + (size_t)k * 262144) = carry; }
    }
}
__device__ __forceinline__ void passc(const Params& p, int half, LAS unsigned char* lds) {
    const int t = otid(), bid = obid(); const int wid = __builtin_amdgcn_readfirstlane(t >> 6), lane = t & 63, quad = wid >> 2, w4 = wid & 3, c16 = lane & 15, q = lane >> 4, pw = w4 * 16;
    for (int item = bid; item < 256; item += gridDim.x) {
    const int h0 = (item & 15) * 2, h = h0 + quad; const float dskip = p.in[18][h];
    f32x4 H[8];
    { const int k = item >> 4;
        if (k == 0) {
#pragma unroll
            for (int nt = 0; nt < 8; ++nt) H[nt] = (f32x4){0.f, 0.f, 0.f, 0.f};
        } else { const float* ST = (const float*)(p.ws + WS_ST) + (((size_t)(k - 1) * 32 + h) * 64 + pw + c16) * 128;
#pragma unroll
            for (int nt = 0; nt < 8; ++nt) H[nt] = *(const f32x4*)(ST + n0_of(nt, q)); }
        ssd_walk<true>(H, lds, p.ws, 8 * k, 8, h0, t, quad, pw, c16, q, dskip);
        if (k == 15) { float* O = p.out + O_SSMP + (((size_t)half * 32 + h) * 64 + pw + c16) * 128;
#pragma unroll
            for (int nt = 0; nt < 8; ++nt) *(f32x4*)(O + n0_of(nt, q)) = H[nt]; } }
    { const int sbl = item >> 4, sb = 16 * half + sbl;
        const float* S0 = p.in[6] + (((size_t)sb * 32 + h) * 64 + pw + c16) * 128;
#pragma unroll
        for (int nt = 0; nt < 8; ++nt) H[nt] = *(const f32x4*)(S0 + n0_of(nt, q));
        ssd_walk<true>(H, lds, p.ws, 128 + sbl, 1, h0, t, quad, pw, c16, q, dskip);
        float* O = p.out + O_SSMS + (((size_t)sb * 32 + h) * 64 + pw + c16) * 128;
#pragma unroll
        for (int nt = 0; nt < 8; ++nt) *(f32x4*)(O + n0_of(nt, q)) = H[nt]; }
    }
}
__device__ __forceinline__ void s5_phase(const Params& p) {
    const int t_ = otid(), bid = obid(); const int lane = t_ & 63, wv = t_ >> 6;
    for (int r = bid * 8 + wv; r < HR; r += gridDim.x * 8) {
        bf16_t* Y = (bf16_t*)(p.ws + WS_X) + (size_t)r * 2048; const bf16_t* Z = (const bf16_t*)(p.ws + WS_Z) + (size_t)r * 2048;
#pragma unroll
        for (int g = 0; g < 4; ++g) { const int c = g * 512 + lane * 8;
            const u32x4 yv = *(const u32x4*)(Y + c), zv = *(const u32x4*)(Z + c);
            const unsigned yw[4] = {yv.x, yv.y, yv.z, yv.w}, zw[4] = {zv.x, zv.y, zv.z, zv.w};
            float v[8]; float ss = 0.f;
#pragma unroll
            for (int j = 0; j < 4; ++j) { v[2 * j] = bflo(yw[j]) * siluf_(bflo(zw[j])); v[2 * j + 1] = bfhi(yw[j]) * siluf_(bfhi(zw[j])); ss += v[2 * j] * v[2 * j] + v[2 * j + 1] * v[2 * j + 1]; }
            ss = wave_sum(ss);
            const float rstd = rsqrtf(ss * (1.0f / 512.0f) + 1e-6f);
            const f32x4 w0 = *(const f32x4*)(p.in[19] + c), w1 = *(const f32x4*)(p.in[19] + c + 4);
            u32x4 o; o.x = cvt_pk_bf16(v[0] * rstd * w0[0], v[1] * rstd * w0[1]); o.y = cvt_pk_bf16(v[2] * rstd * w0[2], v[3] * rstd * w0[3]);
            o.z = cvt_pk_bf16(v[4] * rstd * w1[0], v[5] * rstd * w1[1]); o.w = cvt_pk_bf16(v[6] * rstd * w1[2], v[7] * rstd * w1[3]);
            *(u32x4*)(Y + c) = o; }
    }
}

__device__ __forceinline__ void g_in(const Params& p, int half, LAS unsigned char* lds) { unsigned char* ws = p.ws; pg8::StaticOrder S;
    pg8::Gemm g{(const bf16_t*)(ws + WS_H), (const bf16_t*)(ws + WS_WIN), HR, NINP, 1024, 1024, 1024, 0}; S.init(HR, NINP, gridDim.x, obid());
    EpiIn E{ws, p.out, half}; pg8::gemm_phase(lds, g, S, E); }
__device__ __forceinline__ void g_pool(const Params& p, int half, LAS unsigned char* lds) { unsigned char* ws = p.ws; pg8::StaticOrder S;
    pg8::Gemm g{(const bf16_t*)(ws + WS_H), (const bf16_t*)(ws + WS_WGRP), HR, 1024, 256, 1024, 256, 256}; S.init(HR, 1024, gridDim.x, obid());
    EpiPool E{(bf16_t*)(ws + WS_AM), p.in[13]}; pg8::gemm_phase(lds, g, S, E); }
__device__ __forceinline__ void g_a(const Params& p, int half, LAS unsigned char* lds) { unsigned char* ws = p.ws; pg8::StaticOrder S;
    pg8::Gemm g{(const bf16_t*)(ws + WS_AM), (const bf16_t*)(ws + WS_WA), HR, 1024, 1024, 1024, 1024, 0}; S.init(HR, 1024, gridDim.x, obid());
    EpiA E{(bf16_t*)(ws + WS_H), (const bf16_t*)p.out + 1024, half}; pg8::gemm_phase(lds, g, S, E); }
__device__ __forceinline__ void g_b(const Params& p, int half, LAS unsigned char* lds) { unsigned char* ws = p.ws; pg8::StaticOrder S;
    pg8::Gemm g{(const bf16_t*)(ws + WS_X), (const bf16_t*)(ws + WS_WB), HR, 1024, 2048, 2048, 2048, 0}; S.init(HR, 1024, gridDim.x, obid());
    EpiB E{(bf16_t*)(ws + WS_GB), (const bf16_t*)(ws + WS_H)}; pg8::gemm_phase(lds, g, S, E); }
__device__ __forceinline__ void g_out(const Params& p, int half, LAS unsigned char* lds) { unsigned char* ws = p.ws; pg8::StaticOrder S;
    pg8::Gemm g{(const bf16_t*)(ws + WS_GB), (const bf16_t*)(ws + WS_WOUT), HR, 1024, 1024, 1024, 1024, 0}; S.init(HR, 1024, gridDim.x, obid());
    EpiRes E{p.out, p.in[0], p.in[1], (const float*)(ws + WS_MOD), 2048, half, 0}; pg8::gemm_phase(lds, g, S, E); }
__device__ __forceinline__ void g_f1(const Params& p, int half, LAS unsigned char* lds) { unsigned char* ws = p.ws; pg8::StaticOrder S;
    pg8::Gemm g{(const bf16_t*)(ws + WS_H), (const bf16_t*)(ws + WS_WF1), HR, 5632, 1024, 1024, 1024, 0}; S.init(HR, 5632, gridDim.x, obid());
    EpiF1 E{(bf16_t*)(ws + WS_X)}; pg8::gemm_phase(lds, g, S, E); }
__device__ __forceinline__ void g_f2(const Params& p, int half, LAS unsigned char* lds) { unsigned char* ws = p.ws; pg8::StaticOrder S;
    pg8::Gemm g{(const bf16_t*)(ws + WS_X), (const bf16_t*)(ws + WS_WF2), HR, 1024, DFF, DFF, DFF, 0}; S.init(HR, 1024, gridDim.x, obid());
    EpiRes E{p.out, p.in[0], p.in[1], (const float*)(ws + WS_MOD), 5120, half, 1}; pg8::gemm_phase(lds, g, S, E); }

__global__ void __launch_bounds__(512, 2) mega(Params p) {
    extern __shared__ __attribute__((aligned(16))) unsigned char shm[];
    LAS unsigned char* lds = (LAS unsigned char*)shm;
    volatile LAS unsigned* stw = (volatile LAS unsigned*)(lds + 131072);
    if (threadIdx.x == 0) { stw[0] = 0u; stw[1] = 0u; }
    __syncthreads();
    const XcdBarrier xb = xcd_barrier_post((unsigned*)(p.ws + WS_BAR), stw);
    for (int ph = p.ph_lo; ph < p.ph_hi; ++ph) {
        if (ph > p.ph_lo) { if (ph == 1) cg::this_grid().sync(); else if (ph != 14) xcd_barrier(xb); else __syncthreads(); }
        if (REPEAT_SP == 200 && ph == 1) { for (int zz = 0; zz < 20; ++zz) cg::this_grid().sync(); }
        if (ph == 0) { p0_mod(p, (float*)shm, obid(), gridDim.x);
            if (gridDim.x == 256) { if (obid() >= 96) p0_tiles(p, (float*)shm, 0, P0_EARLY, obid() - 96, 160); } else p0_tiles(p, (float*)shm, 0, P0_EARLY, obid(), gridDim.x);
            continue; }
        if (ph == 27) {
            const size_t i0 = (size_t)obid() * 512 + otid(), st = (size_t)gridDim.x * 512;
            if (DIAG_K < 0) { for (size_t i = i0; i < (size_t)28622848; i += st) { const float v = p.out[i]; if (!(fabsf(v) < 1e30f)) p.out[i] = 0.f; } }
            else {
                for (size_t i = i0; i < (size_t)18874368; i += st) { float a = 0.f;
#define DBF(off, n) { const float v = bf2f((short)((const bf16_t*)(p.ws + (off)))[i % (size_t)(n)]); a += (fabsf(v) < 1e30f) ? v : 777.f; }
#define DF32(off, n) { const float v = ((const float*)(p.ws + (off)))[i % (size_t)(n)]; a += (fabsf(v) < 1e30f) ? v : 777.f; }
                    DF32(WS_MOD, 34 * 6144)
                    if (DIAG_K == 0) { DBF(WS_H, HR * 1024) DBF(WS_WIN, NINP * 1024) DBF(WS_WGRP, 1024 * 256) DBF(WS_WA, 1024 * 1024) DBF(WS_WB, 2048 * 1024) DBF(WS_WOUT, 1024 * 1024) DBF(WS_WF1, 5632 * 1024) DBF(WS_WF2, 2816 * 1024) }
                    if (DIAG_K == 1) { DBF(WS_H, HR * 1024) DBF(WS_Z, HR * 2048) DBF(WS_X, HR * 3072) DBF(WS_GB, HR * 1024) DF32(WS_DTR, HR * 32) }
                    if (DIAG_K == 2) { DBF(WS_H, HR * 1024) DBF(WS_XT, HR * 2048) DBF(WS_BT, NCHK * 4 * 128 * 64) DBF(WS_CM, NCHK * 4 * 128 * 64) DBF(WS_BM, NCHK * 4 * 128 * 64) DF32(WS_DTC, HR * 32) DF32(WS_ACS, HR * 32) }
                    if (DIAG_K == 3) { DBF(WS_AM, HR * 1024) DF32(WS_ST, 15 * 32 * 64 * 128) }
                    if (DIAG_K == 4) { DBF(WS_H, HR * 1024) DF32(WS_ST, 15 * 32 * 64 * 128) }
                    if (DIAG_K == 5 || DIAG_K == 6) { DBF(WS_X, HR * 2048) }
                    if (DIAG_K == 7) { DBF(WS_GB, HR * 1024) }
                    p.out[i] = a; }
                if (DIAG_K < 5) for (size_t i = i0; i < (size_t)524288; i += st) p.out[O_SSMP + i] = 0.f;
                if (DIAG_K < 5) for (size_t i = i0; i < (size_t)8388608; i += st) p.out[O_SSMS + i] = 0.f;
                if (DIAG_K < 2) for (size_t i = i0; i < (size_t)(O_SSMP - O_POOLP); i += st) p.out[O_POOLP + i] = 0.f;
                if (DIAG_K < 2) for (size_t i = i0; i < (size_t)(O_SSMS - O_POOLS); i += st) p.out[O_POOLS + i] = 0.f;
            }
            continue; }
        const int half = (ph - 1) / 13, sp = (ph - 1) % 13;
        if (DIAG_K >= 0 && sp > DIAG_K) continue;
        switch (sp) {
        case 0: norm_phase<0>(p, half); if (REPEAT_SP == 300) { for (int zz = 0; zz < 4; ++zz) norm_phase<0>(p, half); } break;
        case 1: g_in(p, half, lds);
            if (half == 0 && gridDim.x == 256 && obid() >= 164) { __syncthreads(); p0_tiles(p, (float*)shm, P0_EARLY, P0_EARLY + 368, obid() - 164, 92); }
            break;
        case 2: s1_phase(p, half, (float*)shm); if (REPEAT_SP == 301) { __syncthreads(); s1_phase(p, half, (float*)shm); } break;
        case 3: g_pool(p, half, lds); mix1_quads(p, half, lds); break;
        case 4: g_a(p, half, lds); passb(p);
            if (half == 0) { __syncthreads(); const bool g256 = gridDim.x == 256; if (!g256 || obid() >= 144) p0_tiles(p, (float*)shm, g256 ? P0_EARLY + 368 : P0_EARLY, P0_ALL, g256 ? obid() - 144 : obid(), g256 ? 112 : gridDim.x); }
            break;
        case 5: passc(p, half, lds); if (REPEAT_SP == 302) { __syncthreads(); passc(p, half, lds); } break;
        case 6: s5_phase(p); break;
        case 7: g_b(p, half, lds); break;
        case 8: g_out(p, half, lds); if (REPEAT_SP == 303) { __syncthreads(); g_out(p, half, lds); } break;
        case 9: norm_phase<1>(p, half); break;
        case 10: g_f1(p, half, lds); if (REPEAT_SP == 303) { __syncthreads(); g_f1(p, half, lds); } break;
        case 11: g_f2(p, half, lds); break;
        default: norm_phase<2>(p, half); break;
        }
    }
}

extern "C" void kernel_launch(void* const* d_in, const int* in_sizes, int n_in, void* d_out, int out_size, void* d_ws, size_t ws_size, hipStream_t stream) {
    static int grid = 0;
    if (grid == 0) {
        int dev = 0, cus = 0, per_cu = 0;
        (void)hipGetDevice(&dev);
        (void)hipDeviceGetAttribute(&cus, hipDeviceAttributeMultiprocessorCount, dev);
        if (hipFuncSetAttribute((const void*)mega, hipFuncAttributeMaxDynamicSharedMemorySize, LDS_BYTES) != hipSuccess) { fprintf(stderr, "hipFuncSetAttribute failed\n"); grid = -1; return; }
        if (hipOccupancyMaxActiveBlocksPerMultiprocessor(&per_cu, (const void*)mega, 512, LDS_BYTES) != hipSuccess || per_cu < 1) { fprintf(stderr, "occupancy query failed (%d)\n", per_cu); (void)hipGetLastError(); per_cu = 1; }
        grid = cus * 1;
        if (ws_size < WS_END) { fprintf(stderr, "workspace too small: %zu < %zu\n", ws_size, (size_t)WS_END); grid = -1; return; }
    }
    if (grid < 0) return;
    if (hipMemsetAsync((char*)d_ws + WS_BAR, 0, 16384, stream) != hipSuccess) { fprintf(stderr, "memset of barrier words failed\n"); return; }
    Params p{};
    for (int i = 0; i < 27; ++i) p.in[i] = (const float*)d_in[i];
    p.out = (float*)d_out; p.ws = (unsigned char*)d_ws;
#if MULTI_LAUNCH
    for (int ph = 0; ph < NPHASE; ++ph) { p.ph_lo = ph; p.ph_hi = ph + 1; hipLaunchKernelGGL(mega, dim3(grid), dim3(512), LDS_BYTES, stream, p); }
#else
    p.ph_lo = 0; p.ph_hi = NPHASE;
    void* args[] = {&p};
    hipError_t e = hipLaunchCooperativeKernel((const void*)mega, dim3(grid), dim3(512), args, LDS_BYTES, stream);
    if (e != hipSuccess) fprintf(stderr, "cooperative launch failed: %s (grid %d)\n", hipGetErrorString(e), grid);
#endif
}
```
